# Optimizing an MI355X kernel written in HIP

```python
import jax, jax.numpy as jnp
from jax import lax
import numpy as np

D_MODEL = 1024
BATCH = 8
SEQ = 4096
DEPTH = 4

N_EVEN = (DEPTH + 1) // 2
N_ODD = DEPTH // 2

A_WIDTH = D_MODEL // 2
A_HEADS = 4
A_HEAD_DIM = A_WIDTH // A_HEADS
MLSTM_CHUNK = 128
CONV_WIDTH = 5

B_WIDTH = D_MODEL - A_WIDTH
B_GROUPS = 4
B_GROUP_DIM = B_WIDTH // B_GROUPS
SGU_CHUNK = 128

AB_IN = 4 * A_WIDTH + 4 * A_HEADS + 2 * B_WIDTH

C_HEADS = 16
C_NOPE = 64
C_ROPE = 32
C_V = 64
Q_LORA = 384
KV_LORA = 256
C_IN = Q_LORA + KV_LORA + C_ROPE
ROPE_BASE = 10000.0
Q_BLOCK = 128

D_FF = 4 * D_MODEL

EPS = 1e-6

kernel_name = "hybrid_mlstm_sgu_mla_encoder"


def rms_norm(x, g):
    xf = x.astype(jnp.float32)
    y = xf * lax.rsqrt(jnp.mean(xf * xf, axis=-1, keepdims=True) + EPS)
    return (y * g.astype(jnp.float32)).astype(x.dtype)


def centred_dwconv(x, w):
    pad = (w.shape[0] - 1) // 2
    return lax.conv_general_dilated(
        x, w[:, None, :].astype(x.dtype), window_strides=(1,),
        padding=[(pad, pad)], dimension_numbers=("NWC", "WIO", "NWC"),
        feature_group_count=x.shape[-1])


def mlstm_scan(q, k, v, log_i, log_f):
    bsz, nh, seq, dh = q.shape
    L = MLSTM_CHUNK
    nc = seq // L

    def to_chunks(t):
        return jnp.moveaxis(t.reshape(bsz, nh, nc, L, *t.shape[3:]), 2, 0)

    lower = jnp.tril(jnp.ones((L, L), dtype=bool))

    def step(carry, xs):
        C, n, m = carry
        qc, kc, vc, li, lf = xs
        b = jnp.cumsum(lf, axis=-1)
        dmat = jnp.where(lower, b[..., :, None] - b[..., None, :] + li[..., None, :], -jnp.inf)
        m_t = jnp.maximum(b + m[..., None], jnp.max(dmat, axis=-1))
        inter = jnp.exp(b + m[..., None] - m_t)
        s = jnp.einsum("bhtd,bhsd->bhts", qc, kc) * jnp.exp(dmat - m_t[..., None])
        num = (jnp.einsum("bhts,bhse->bhte", s, vc)
               + inter[..., None] * jnp.einsum("bhtd,bhde->bhte", qc, C))
        den = jnp.sum(s, axis=-1) + inter * jnp.einsum("bhtd,bhd->bht", qc, n)
        h = num / jnp.maximum(jnp.abs(den), jnp.exp(-m_t))[..., None]
        g = b[..., -1]
        w_log = g[..., None] - b + li
        m_new = jnp.maximum(g + m, jnp.max(w_log, axis=-1))
        decay = jnp.exp(g + m - m_new)
        w = jnp.exp(w_log - m_new[..., None])
        C_new = decay[..., None, None] * C + jnp.einsum("bhs,bhsd,bhse->bhde", w, kc, vc)
        n_new = decay[..., None] * n + jnp.einsum("bhs,bhsd->bhd", w, kc)
        return (C_new, n_new, m_new), h

    init = (jnp.zeros((bsz, nh, dh, dh), jnp.float32),
            jnp.zeros((bsz, nh, dh), jnp.float32),
            jnp.zeros((bsz, nh), jnp.float32))
    _, h = lax.scan(step, init, (to_chunks(q), to_chunks(k), to_chunks(v),
                                 to_chunks(log_i), to_chunks(log_f)))
    return jnp.moveaxis(h, 0, 2).reshape(bsz, nh, seq, dh)


def ab_mixer(h, w_in, conv_w, gate_b, head_g, v_g, ws, bs, w_out):
    bsz, seq, _ = h.shape
    p = h @ w_in
    qk, va, oa, gates, uv = jnp.split(
        p, [2 * A_WIDTH, 3 * A_WIDTH, 4 * A_WIDTH, 4 * A_WIDTH + 4 * A_HEADS], axis=-1)

    qk = jax.nn.silu(centred_dwconv(qk, conv_w))

    def heads(t):
        return t.reshape(bsz, seq, A_HEADS, A_HEAD_DIM).transpose(0, 2, 1, 3).astype(jnp.float32)

    q = heads(qk[..., :A_WIDTH]) * (A_HEAD_DIM ** -0.5)
    k = heads(qk[..., A_WIDTH:])
    v = heads(va)
    g = (gates + gate_b).astype(jnp.float32).reshape(bsz, seq, 4, A_HEADS).transpose(2, 0, 3, 1)
    li_f, lf_f = g[0], jax.nn.log_sigmoid(g[1])
    li_b, lf_b = g[2], jax.nn.log_sigmoid(g[3])
    h_fwd = mlstm_scan(q, k, v, li_f, lf_f)
    fl = lambda t: jnp.flip(t, axis=2)
    h_bwd = fl(mlstm_scan(fl(q), fl(k), fl(v), jnp.flip(li_b, -1), jnp.flip(lf_b, -1)))
    ha = rms_norm(h_fwd + h_bwd, head_g.reshape(A_HEADS, 1, A_HEAD_DIM))
    ha = ha.transpose(0, 2, 1, 3).reshape(bsz, seq, A_WIDTH).astype(h.dtype) * jax.nn.sigmoid(oa)

    u, vb = jnp.split(jax.nn.gelu(uv), 2, axis=-1)
    vb = rms_norm(vb.reshape(bsz, seq, B_GROUPS, B_GROUP_DIM), v_g.reshape(B_GROUPS, B_GROUP_DIM))
    vb = vb.reshape(bsz, seq // SGU_CHUNK, SGU_CHUNK, B_GROUPS, B_GROUP_DIM)
    sp = jnp.einsum("gts,bnsgc->bntgc", ws, vb) + bs.T[:, :, None]
    hb = u * sp.reshape(bsz, seq, B_WIDTH)

    return jnp.concatenate([ha, hb], axis=-1) @ w_out


def apply_rope(x, cos, sin):
    half = x.shape[-1] // 2
    x1, x2 = x[..., :half], x[..., half:]
    return jnp.concatenate([x1 * cos - x2 * sin, x1 * sin + x2 * cos], axis=-1).astype(x.dtype)


def mla_mixer(h, positions, w_in, q_g, kv_g, w_uq, w_ukv, w_out):
    bsz, seq, _ = h.shape
    cq, ckv, kr = jnp.split(h @ w_in, [Q_LORA, Q_LORA + KV_LORA], axis=-1)
    q = (rms_norm(cq, q_g) @ w_uq).reshape(bsz, seq, C_HEADS, C_NOPE + C_ROPE)
    kv = (rms_norm(ckv, kv_g) @ w_ukv).reshape(bsz, seq, C_HEADS, C_NOPE + C_V)

    half = C_ROPE // 2
    freq = ROPE_BASE ** (-jnp.arange(half, dtype=jnp.float32) / half)
    ang = positions.astype(jnp.float32)[..., None] * freq
    cos = jnp.cos(ang)[:, :, None, :]
    sin = jnp.sin(ang)[:, :, None, :]
    q_rope = apply_rope(q[..., C_NOPE:], cos, sin)
    k_rope = apply_rope(kr[:, :, None, :], cos, sin)
    qf = jnp.concatenate([q[..., :C_NOPE], q_rope], axis=-1)
    kf = jnp.concatenate([kv[..., :C_NOPE],
                          jnp.broadcast_to(k_rope, (bsz, seq, C_HEADS, C_ROPE))], axis=-1)
    v = kv[..., C_NOPE:]
    scale = (C_NOPE + C_ROPE) ** -0.5

    qb = jnp.moveaxis(qf.reshape(bsz, seq // Q_BLOCK, Q_BLOCK, C_HEADS, C_NOPE + C_ROPE), 1, 0)

    def attend(qblk):
        s = jnp.einsum("bqhd,bkhd->bhqk", qblk, kf, preferred_element_type=jnp.float32) * scale
        pr = jax.nn.softmax(s, axis=-1)
        return jnp.einsum("bhqk,bkhd->bqhd", pr.astype(v.dtype), v)

    o = lax.map(attend, qb)
    o = jnp.moveaxis(o, 0, 1).reshape(bsz, seq, C_HEADS * C_V)
    return o @ w_out


def setup_inputs(seed: int = 0) -> dict:
    key = jax.random.key(seed)
    ks = iter(jax.random.split(key, 40))
    f32 = jnp.float32

    def nrm(shape, scale):
        return jax.random.normal(next(ks), shape, f32) * scale

    def gain(shape):
        return 1.0 + 0.02 * jax.random.normal(next(ks), shape, f32)

    x = jax.random.normal(next(ks), (BATCH, SEQ, D_MODEL), f32)
    offsets = jax.random.randint(next(ks), (BATCH, 1), 0, 1024, dtype=jnp.int32)
    positions = offsets + jnp.arange(SEQ, dtype=jnp.int32)[None, :]

    forget_b = jnp.linspace(3.0, 6.0, A_HEADS, dtype=f32)
    gate_b = jnp.concatenate([
        nrm((N_EVEN, A_HEADS), 0.1),
        forget_b + nrm((N_EVEN, A_HEADS), 0.1),
        nrm((N_EVEN, A_HEADS), 0.1),
        forget_b + nrm((N_EVEN, A_HEADS), 0.1)], axis=-1)

    return {
        "x": x,
        "positions": positions,
        "ab_norm": gain((N_EVEN, D_MODEL)),
        "ab_w_in": nrm((N_EVEN, D_MODEL, AB_IN), D_MODEL ** -0.5),
        "ab_conv": nrm((N_EVEN, CONV_WIDTH, 2 * A_WIDTH), CONV_WIDTH ** -0.5),
        "ab_gate_b": gate_b,
        "ab_head_g": gain((N_EVEN, A_WIDTH)),
        "ab_v_g": gain((N_EVEN, B_WIDTH)),
        "ab_ws": nrm((N_EVEN, B_GROUPS, SGU_CHUNK, SGU_CHUNK), SGU_CHUNK ** -0.5),
        "ab_bs": gain((N_EVEN, B_GROUPS, SGU_CHUNK)),
        "ab_w_out": nrm((N_EVEN, A_WIDTH + B_WIDTH, D_MODEL), (A_WIDTH + B_WIDTH) ** -0.5),
        "c_norm": gain((N_ODD, D_MODEL)),
        "c_w_in": nrm((N_ODD, D_MODEL, C_IN), D_MODEL ** -0.5),
        "c_q_g": gain((N_ODD, Q_LORA)),
        "c_kv_g": gain((N_ODD, KV_LORA)),
        "c_w_uq": nrm((N_ODD, Q_LORA, C_HEADS * (C_NOPE + C_ROPE)), Q_LORA ** -0.5),
        "c_w_ukv": nrm((N_ODD, KV_LORA, C_HEADS * (C_NOPE + C_V)), KV_LORA ** -0.5),
        "c_w_out": nrm((N_ODD, C_HEADS * C_V, D_MODEL), (C_HEADS * C_V) ** -0.5),
        "ffn_norm": gain((DEPTH, D_MODEL)),
        "ffn_w1": nrm((DEPTH, D_MODEL, D_FF), D_MODEL ** -0.5),
        "ffn_w2": nrm((DEPTH, D_FF, D_MODEL), D_FF ** -0.5),
        "final_norm": gain((D_MODEL,)),
    }


def reference(x, positions, ab_norm, ab_w_in, ab_conv, ab_gate_b, ab_head_g, ab_v_g,
              ab_ws, ab_bs, ab_w_out, c_norm, c_w_in, c_q_g, c_kv_g, c_w_uq, c_w_ukv,
              c_w_out, ffn_norm, ffn_w1, ffn_w2, final_norm):
    for layer in range(DEPTH):
        j = layer // 2
        if layer % 2 == 0:
            x = x + ab_mixer(rms_norm(x, ab_norm[j]), ab_w_in[j], ab_conv[j], ab_gate_b[j],
                             ab_head_g[j], ab_v_g[j], ab_ws[j], ab_bs[j], ab_w_out[j])
        else:
            x = x + mla_mixer(rms_norm(x, c_norm[j]), positions, c_w_in[j], c_q_g[j],
                              c_kv_g[j], c_w_uq[j], c_w_ukv[j], c_w_out[j])
        hf = rms_norm(x, ffn_norm[layer])
        x = x + jnp.square(jax.nn.relu(hf @ ffn_w1[layer])) @ ffn_w2[layer]
    return rms_norm(x, final_norm)
```

```cpp
#include <hip/hip_runtime.h>
#include <hip/hip_cooperative_groups.h>
#include <cstdio>
namespace cg = cooperative_groups;

#ifndef DUP_MASK
#define DUP_MASK 0
#endif
#ifndef MK_MULTI
#define MK_MULTI 0
#endif

#define LAS __attribute__((address_space(3)))
typedef unsigned short bf16_t;
typedef short bf16x8 __attribute__((ext_vector_type(8)));
typedef short s16x4 __attribute__((ext_vector_type(4)));
typedef float f32x4 __attribute__((ext_vector_type(4)));
typedef float f32x16 __attribute__((ext_vector_type(16)));
typedef unsigned u32x4 __attribute__((ext_vector_type(4)));
typedef unsigned u32x2 __attribute__((ext_vector_type(2)));

constexpr int NB = 8, SEQ = 4096, DM = 1024, TOK = NB * SEQ;
constexpr int ABN = 3088;
constexpr int PNG = 3104;
constexpr int PN = 3072;
constexpr int CIN = 672, CINP = 768;
constexpr int QL = 384, KVL = 256;
constexpr int NQ = 1536, NKV = 2048;
constexpr int DFF = 4096;
constexpr float EPS = 1e-6f;

constexpr size_t MiB = 1u << 20;
constexpr size_t WS_ROPE = 1 * MiB;
constexpr size_t WS_GATES = 5 * MiB;
constexpr size_t WS_STAT = 7 * MiB;
constexpr size_t WS_MPREV = 7 * MiB + 65536;
constexpr size_t WS_NLOC = 8 * MiB;
constexpr size_t WS_SS = 10 * MiB;
constexpr size_t WS_W = 12 * MiB;
constexpr size_t W_ABIN = WS_W;
constexpr size_t W_ABOUT = W_ABIN + 2ull * PNG * DM * 2;
constexpr size_t W_CIN = W_ABOUT + 2ull * DM * DM * 2;
constexpr size_t W_CUQ = W_CIN + 2ull * CINP * DM * 2;
constexpr size_t W_CUKV = W_CUQ + 2ull * NQ * QL * 2;
constexpr size_t W_COUT = W_CUKV + 2ull * NKV * KVL * 2;
constexpr size_t W_F1 = W_COUT + 2ull * DM * DM * 2;
constexpr size_t W_F2 = W_F1 + 4ull * DFF * DM * 2;
constexpr size_t W_END = W_F2 + 4ull * DFF * DM * 2;
static_assert(W_END <= 108 * MiB, "weights fit");
constexpr size_t WS_HAB = 108 * MiB;
constexpr size_t WS_BIG = 172 * MiB;
constexpr size_t WS_XN = 428 * MiB;
constexpr size_t WS_CLOC = WS_BIG + 192 * MiB;
constexpr size_t WS_END = 492 * MiB;
constexpr size_t WS_KV = WS_BIG + 96 * MiB;
constexpr size_t WS_CQN = WS_XN, WS_CKVN = WS_XN + 24 * MiB, WS_KR = WS_XN + 40 * MiB;

constexpr int LDS_BYTES = 155648;
constexpr int NTHR = 512;

__device__ __forceinline__ unsigned f2bf(float f) { unsigned u = __builtin_bit_cast(unsigned, f); return (u + 0x7fffu + ((u >> 16) & 1u)) >> 16; }
__device__ __forceinline__ unsigned pk2(float lo, float hi) { return f2bf(lo) | (f2bf(hi) << 16); }
__device__ __forceinline__ float bflo(unsigned w) { return __builtin_bit_cast(float, w << 16); }
__device__ __forceinline__ float bfhi(unsigned w) { return __builtin_bit_cast(float, w & 0xffff0000u); }
__device__ __forceinline__ float bf2f(bf16_t b) { return __builtin_bit_cast(float, ((unsigned)b) << 16); }
__device__ __forceinline__ unsigned cvtpk(float lo, float hi) { unsigned r; asm volatile("v_cvt_pk_bf16_f32 %0, %1, %2" : "=v"(r) : "v"(lo), "v"(hi)); return r; }
__device__ __forceinline__ float wave_sum(float v) {
#pragma unroll
    for (int o = 1; o < 64; o <<= 1) v += __shfl_xor(v, o);
    return v;
}
__device__ __forceinline__ float rows4_sum(float x) {
    { auto r = __builtin_amdgcn_permlane16_swap(__float_as_uint(x), __float_as_uint(x), false, false); x = __uint_as_float(r[0]) + __uint_as_float(r[1]); }
    { auto r = __builtin_amdgcn_permlane32_swap(__float_as_uint(x), __float_as_uint(x), false, false); x = __uint_as_float(r[0]) + __uint_as_float(r[1]); }
    return x;
}
__device__ __forceinline__ void unpack8(u32x4 w, float* x) {
    x[0] = bflo(w.x); x[1] = bfhi(w.x); x[2] = bflo(w.y); x[3] = bfhi(w.y); x[4] = bflo(w.z); x[5] = bfhi(w.z); x[6] = bflo(w.w); x[7] = bfhi(w.w);
}
#define LDS_WAIT() asm volatile("s_waitcnt lgkmcnt(0)" ::: "memory")

namespace pg8 {
constexpr int BM = 256, BK = 64, HALF = 128, HTB = HALF * BK * 2, STAGE_BYTES = 8 * HTB, NXCD = 8, WGM = 8;
__device__ __forceinline__ int lds_byte(int r, int c) { const int st = (r >> 4) * 2 + (c >> 5), rr = r & 15, cc = c & 31, ob = rr * 64 + cc * 2; return st * 1024 + (ob ^ (((ob >> 9) & 1) << 5)); }
__device__ __forceinline__ void stage_rc(int b, int& R, int& C) { const int st = b / 1024, sb = b % 1024, swz = sb ^ (((sb >> 9) & 1) << 5); R = (st >> 1) * 16 + swz / 64; C = (st & 1) * 32 + (swz % 64) / 2; }
__device__ __forceinline__ int perm32(int rho) { const int n = rho >> 4, i = rho & 15; return 8 * (i >> 2) + 4 * n + (i & 3); }
struct Unit { int pm, pn, idx; };
struct Gemm { const bf16_t* A; const bf16_t* Bt; int M, N, K; };
struct StaticOrder {
    int nM, nN, nwg, G, c;
    __device__ void init(int M, int N, int G_, int c_) { nM = M / BM; nN = N / BM; nwg = nM * nN; G = G_; c = c_; }
    __device__ bool next(int i, Unit& u) const {
        const long L = (long)i * G + c; if (L >= nwg) return false;
        int wgid = (int)L; { const int q = nwg / NXCD, r = nwg % NXCD, xcd = wgid % NXCD, off = wgid / NXCD; wgid = (xcd < r ? xcd * (q + 1) : r * (q + 1) + (xcd - r) * q) + off; }
        const int nig = WGM * nN, gid = wgid / nig, fm = gid * WGM, gsz = (nM - fm) < WGM ? (nM - fm) : WGM;
        u.pm = fm + ((wgid % nig) % gsz); u.pn = (wgid % nig) / gsz; u.idx = i; return true;
    }
};
struct EpiRes {
    static constexpr bool PERM = false;
    const bf16_t* base; bf16_t* out; float* ss;
    __device__ __forceinline__ void operator()(const f32x4 (&acc)[2][2][4][2], const Unit& u, int wr, int wc, int fr, int fq) const {
        const int row0 = u.pm * BM + wr * 64 + fr, col0 = u.pn * BM + wc * 32 + 4 * fq;
#pragma unroll
        for (int ai = 0; ai < 2; ++ai) {
            u32x2 b[4][2][2];
#pragma unroll
            for (int m = 0; m < 4; ++m)
#pragma unroll
                for (int bj = 0; bj < 2; ++bj)
#pragma unroll
                    for (int n = 0; n < 2; ++n) b[m][bj][n] = *(const u32x2*)(base + (size_t)(row0 + ai * HALF + m * 16) * DM + col0 + bj * HALF + n * 16);
            asm volatile("" ::: "memory");
#pragma unroll
            for (int m = 0; m < 4; ++m) { const int row = row0 + ai * HALF + m * 16; const size_t off = (size_t)row * DM + col0; float sq = 0.f;
#pragma unroll
                for (int bj = 0; bj < 2; ++bj)
#pragma unroll
                    for (int n = 0; n < 2; ++n) { const size_t o = off + bj * HALF + n * 16; const u32x2 bw = b[m][bj][n];
                        const f32x4 v = (f32x4){bflo(bw.x), bfhi(bw.x), bflo(bw.y), bfhi(bw.y)} + acc[ai][bj][m][n];
                        u32x2 w; w.x = cvtpk(v.x, v.y); w.y = cvtpk(v.z, v.w); *(u32x2*)(out + o) = w;
                        const float r0 = bflo(w.x), r1 = bfhi(w.x), r2 = bflo(w.y), r3 = bfhi(w.y);
                        sq += (r0 * r0 + r1 * r1) + (r2 * r2 + r3 * r3); }
                sq = rows4_sum(sq);
                if (fq == 0) ss[(size_t)row * 16 + u.pn * 4 + wc] = sq; }
            asm volatile("" ::: "memory"); }
    }
};
struct EpiBf {
    static constexpr bool PERM = true;
    bf16_t* O; int ldc; int act; const LAS float* rst; float* gates; const float* gate_b;
    __device__ __forceinline__ void operator()(const f32x4 (&acc)[2][2][4][2], const Unit& u, int wr, int wc, int fr, int fq) const {
        const int row0 = u.pm * BM + wr * 64 + fr, col0 = u.pn * BM + wc * 32 + 8 * fq;
        const int a = (act == 2) ? ((u.pn >= 8) ? 2 : 0) : act;
        const bool gate_tile = (act == 2) && (u.pn == 12);
        if (gate_tile && !(wc == 0 && fq < 2)) return;
#pragma unroll
        for (int ai = 0; ai < 2; ++ai)
#pragma unroll
            for (int m = 0; m < 4; ++m) { const int row = row0 + ai * HALF + m * 16;
                const float rs = rst ? rst[u.idx * 256 + (row - u.pm * BM)] : 1.f;
                if (gate_tile) {
#pragma unroll
                    for (int n = 0; n < 2; ++n) { const int q0 = 8 * fq + 4 * n; f32x4 x = acc[ai][0][m][n] * rs + *(const f32x4*)(gate_b + q0);
                        if ((q0 >> 2) & 1) {
#pragma unroll
                            for (int j = 0; j < 4; ++j) x[j] = fminf(x[j], 0.f) - log1pf(__expf(-fabsf(x[j]))); }
                        *(f32x4*)(gates + (size_t)row * 16 + q0) = x; }
                    continue; }
                bf16_t* rowp = O + (size_t)row * ldc + col0;
#pragma unroll
                for (int bj = 0; bj < 2; ++bj) { float v[8];
#pragma unroll
                    for (int j = 0; j < 4; ++j) { v[j] = acc[ai][bj][m][0][j] * rs; v[4 + j] = acc[ai][bj][m][1][j] * rs; }
                    if (a == 1) {
#pragma unroll
                        for (int j = 0; j < 8; ++j) { const float r = fmaxf(v[j], 0.f); v[j] = r * r; }
                    } else if (a == 2) {
#pragma unroll
                        for (int j = 0; j < 8; ++j) { const float x = v[j]; const float z = 0.7978845608028654f * (x + 0.044715f * x * x * x);
                            const float e = __builtin_amdgcn_exp2f(z * 2.885390081777927f); v[j] = x * (1.f - __builtin_amdgcn_rcpf(1.f + e)); }
                    }
                    u32x4 w; w.x = cvtpk(v[0], v[1]); w.y = cvtpk(v[2], v[3]); w.z = cvtpk(v[4], v[5]); w.w = cvtpk(v[6], v[7]);
                    *(u32x4*)(rowp + bj * HALF) = w; } }
    }
};

template <class Epi>
__device__ __forceinline__ void gemm_phase(LAS unsigned char* lds, const Gemm g, const StaticOrder& S, const Epi& E, const int tid) {
    const int wid = __builtin_amdgcn_readfirstlane(tid >> 6), lane = tid & 63, wr = wid >> 2, wc = wid & 3, fr = lane & 15, fq = lane >> 4;
    const int K = g.K, nt = K / BK;
    unsigned voffA[2], voffB[2];
#pragma unroll
    for (int i = 0; i < 2; ++i) { int R, C; stage_rc(tid * 16 + i * 8192, R, C); const int Rb = Epi::PERM ? ((R & ~31) + perm32(R & 31)) : R;
        voffA[i] = (unsigned)(R * K + C) * 2u; voffB[i] = (unsigned)(Rb * K + C) * 2u; }
    const size_t kstep = (size_t)(BK * 2);
    const size_t hstep = (size_t)HALF * K * 2;
    const size_t tstep = 2 * hstep;
    const unsigned ldsw = (unsigned)wid * 1024u;
    const int aoff = lds_byte(wr * 64 + fr, fq * 8), boff = lds_byte(wc * 32 + fr, fq * 8);
#define PG8_SA(b, h) (((b) * 2 + (h)) * HTB)
#define PG8_SB(b, h) ((4 + (b) * 2 + (h)) * HTB)
#define PG8_STAGE(bufoff, gbase, voff) do { _Pragma("unroll") for (int _i = 0; _i < 2; ++_i) \
        __builtin_amdgcn_global_load_lds((const unsigned*)((const char*)(gbase) + (voff)[_i]), (LAS unsigned*)(lds + (bufoff) + ldsw + _i * 8192), 16, 0, 0); } while (0)
#define PG8_LDA(dst, b, h) do { _Pragma("unroll") for (int m = 0; m < 4; ++m) _Pragma("unroll") for (int k = 0; k < 2; ++k) dst[m][k] = *(const LAS bf16x8*)(lds + PG8_SA(b, h) + aoff + m * 2048 + k * 1024); } while (0)
#define PG8_LDB(dst, b, h) do { _Pragma("unroll") for (int n = 0; n < 2; ++n) _Pragma("unroll") for (int k = 0; k < 2; ++k) dst[n][k] = *(const LAS bf16x8*)(lds + PG8_SB(b, h) + boff + n * 2048 + k * 1024); } while (0)
#define PG8_MMA(ai, bj, At, Bt) do { __builtin_amdgcn_s_setprio(1); _Pragma("unroll") for (int m = 0; m < 4; ++m) _Pragma("unroll") for (int n = 0; n < 2; ++n) _Pragma("unroll") for (int k = 0; k < 2; ++k) \
        acc[ai][bj][m][n] = __builtin_amdgcn_mfma_f32_16x16x32_bf16(Bt[n][k], At[m][k], acc[ai][bj][m][n], 0, 0, 0); __builtin_amdgcn_s_setprio(0); } while (0)
#define PG8_WAIT_V(n) asm volatile("s_waitcnt vmcnt(" #n ")" ::: "memory")
#define PG8_WAIT_L(n) asm volatile("s_waitcnt lgkmcnt(" #n ")" ::: "memory")
#define PG8_BAR __builtin_amdgcn_s_barrier()
#define PG8_SCHED __builtin_amdgcn_sched_barrier(0)
    Unit cur, nxt; int ui = 0;
    if (!S.next(0, cur)) return;
    f32x4 acc[2][2][4][2];
#pragma unroll
    for (int a = 0; a < 2; ++a)
#pragma unroll
        for (int b = 0; b < 2; ++b)
#pragma unroll
            for (int m = 0; m < 4; ++m)
#pragma unroll
                for (int n = 0; n < 2; ++n) acc[a][b][m][n] = (f32x4){0.f, 0.f, 0.f, 0.f};
    bf16x8 At[4][2], B0[2][2], B1[2][2];
    const char* cA = (const char*)g.A + (size_t)cur.pm * tstep; const char* cB = (const char*)g.Bt + (size_t)cur.pn * tstep;
    PG8_STAGE(PG8_SB(0, 0), cB, voffB); PG8_STAGE(PG8_SB(0, 1), cB + hstep, voffB); PG8_STAGE(PG8_SA(0, 0), cA, voffA); PG8_STAGE(PG8_SA(0, 1), cA + hstep, voffA);
    if (wr == 1) PG8_BAR;
    PG8_WAIT_V(2); PG8_BAR;
    PG8_STAGE(PG8_SB(1, 0), cB + kstep, voffB); PG8_STAGE(PG8_SA(1, 0), cA + kstep, voffA); PG8_STAGE(PG8_SB(1, 1), cB + hstep + kstep, voffB);
    PG8_WAIT_V(6); PG8_BAR;
    for (;;) {
        const bool has_next = S.next(ui + 1, nxt);
        const char* nA = has_next ? (const char*)g.A + (size_t)nxt.pm * tstep : cA; const char* nB = has_next ? (const char*)g.Bt + (size_t)nxt.pn * tstep : cB;
        for (int t = 0; t < nt; t += 2) {
            const bool last = (t == nt - 2);
            const char* a1 = cA + (size_t)(t + 1) * kstep;
            const char* a2 = last ? nA : cA + (size_t)(t + 2) * kstep; const char* b2 = last ? nB : cB + (size_t)(t + 2) * kstep;
            const char* a3 = a2 + kstep; const char* b3 = b2 + kstep;
            PG8_LDB(B0, 0, 0); PG8_LDB(B1, 0, 1); PG8_SCHED; PG8_LDA(At, 0, 0); PG8_STAGE(PG8_SA(1, 1), a1 + hstep, voffA);
            PG8_WAIT_V(8); PG8_WAIT_L(0); PG8_BAR; PG8_MMA(0, 0, At, B0); PG8_MMA(0, 1, At, B1); PG8_BAR; PG8_SCHED;
            PG8_LDA(At, 0, 1); PG8_STAGE(PG8_SB(0, 0), b2, voffB); PG8_STAGE(PG8_SB(0, 1), b2 + hstep, voffB); PG8_STAGE(PG8_SA(0, 0), a2, voffA);
            PG8_WAIT_V(8); PG8_WAIT_L(0); PG8_BAR; PG8_MMA(1, 0, At, B0); PG8_MMA(1, 1, At, B1); PG8_BAR; PG8_SCHED;
            PG8_LDB(B0, 1, 0); PG8_LDB(B1, 1, 1); PG8_SCHED; PG8_LDA(At, 1, 0); PG8_STAGE(PG8_SA(0, 1), a2 + hstep, voffA);
            PG8_WAIT_V(8); PG8_WAIT_L(0); PG8_BAR; PG8_MMA(0, 0, At, B0); PG8_MMA(0, 1, At, B1); PG8_BAR; PG8_SCHED;
            PG8_LDA(At, 1, 1); PG8_STAGE(PG8_SB(1, 0), b3, voffB); PG8_STAGE(PG8_SB(1, 1), b3 + hstep, voffB); PG8_STAGE(PG8_SA(1, 0), a3, voffA);
            PG8_WAIT_V(8); PG8_WAIT_L(0); PG8_BAR; PG8_MMA(1, 0, At, B0); PG8_MMA(1, 1, At, B1); PG8_BAR; PG8_SCHED;
        }
        if (wr == 0) PG8_BAR;
        E(acc, cur, wr, wc, fr, fq);
        if (!has_next) break;
#pragma unroll
        for (int a = 0; a < 2; ++a)
#pragma unroll
            for (int b = 0; b < 2; ++b)
#pragma unroll
                for (int m = 0; m < 4; ++m)
#pragma unroll
                    for (int n = 0; n < 2; ++n) acc[a][b][m][n] = (f32x4){0.f, 0.f, 0.f, 0.f};
        cur = nxt; cA = nA; cB = nB; ++ui;
        if (wr == 1) PG8_BAR;
    }
    PG8_WAIT_V(0);
    PG8_BAR;
#undef PG8_SA
#undef PG8_SB
#undef PG8_STAGE
#undef PG8_LDA
#undef PG8_LDB
#undef PG8_MMA
#undef PG8_WAIT_V
#undef PG8_WAIT_L
#undef PG8_BAR
#undef PG8_SCHED
}
}

struct Params {
    const float* in[22];
    float* out; unsigned char* ws;
    int ph_lo, ph_hi;
};
enum { I_X = 0, I_POS, I_ABNORM, I_ABWIN, I_ABCONV, I_ABGB, I_ABHG, I_ABVG, I_ABWS, I_ABBS, I_ABWOUT, I_CNORM, I_CWIN, I_CQG, I_CKVG, I_CWUQ, I_CWUKV, I_CWOUT,
       I_FNORM, I_FW1, I_FW2, I_FINAL };

typedef const __attribute__((address_space(4))) Params* PP;
struct Ctx { LAS unsigned char* lds; int tid, lane, wave, vcu, G; };

__device__ __forceinline__ void transpose_weight(const Ctx& C, const float* W, int K, int ld, int c0, int ncols, bf16_t* WT, int r0, const float* gk = nullptr) {
    LAS float* scr = (LAS float*)(C.lds + C.wave * 16384);
    const int gw = C.vcu * 8 + C.wave, NGW = C.G * 8, lane = C.lane;
    const int nblk = ncols / 32, nitems = (K / 64) * nblk;
    for (int item = gw; item < nitems; item += NGW) {
        const int kb = item / nblk, nb = item % nblk, k0 = 64 * kb, n0 = 32 * nb;
#pragma unroll
        for (int i = 0; i < 32; ++i) { const int kk = 2 * i + (lane >> 5); scr[kk * 33 + (lane & 31)] = W[(size_t)(k0 + kk) * ld + c0 + n0 + (lane & 31)] * (gk ? gk[k0 + kk] : 1.f); }
        LDS_WAIT(); asm volatile("" ::: "memory");
        const int c = lane & 7;
#pragma unroll
        for (int j = 0; j < 4; ++j) { const int n = (lane >> 3) + 8 * j; const LAS float* s = scr + (8 * c) * 33 + n;
            u32x4 o; o.x = pk2(s[0 * 33], s[1 * 33]); o.y = pk2(s[2 * 33], s[3 * 33]); o.z = pk2(s[4 * 33], s[5 * 33]); o.w = pk2(s[6 * 33], s[7 * 33]);
            *(u32x4*)(WT + (size_t)(r0 + n0 + n) * K + k0 + 8 * c) = o; }
        LDS_WAIT(); asm volatile("" ::: "memory");
    }
}
struct TDesc { const float* W; bf16_t* WT; const float* gk; int K, ld; };
constexpr int TI_FFN = 4 * 4096, TI_J = 1024 + 512 + 16 + 512 + 336 + 288 + 256 + 512, TI_ALL = TI_FFN + 2 * TI_J;
__device__ __forceinline__ TDesc tdecode(PP p, unsigned char* ws, int it) {
    TDesc d; const float* W; bf16_t* WT; const float* gk = nullptr; int K, ld, c0 = 0, r0 = 0, nblk, r;
    if (it < TI_FFN) { const int l = it >> 12; r = it & 4095;
        if (r < 2048) { W = p->in[I_FW1] + (size_t)l * DM * DFF; K = DM; ld = DFF; nblk = 128; WT = (bf16_t*)(ws + W_F1) + (size_t)l * DFF * DM; gk = p->in[I_FNORM] + (size_t)l * DM; }
        else { r -= 2048; W = p->in[I_FW2] + (size_t)l * DFF * DM; K = DFF; ld = DM; nblk = 32; WT = (bf16_t*)(ws + W_F2) + (size_t)l * DM * DFF; }
    } else { const int i2 = it - TI_FFN, j = i2 / TI_J; r = i2 % TI_J;
        if (r < 1552) { W = p->in[I_ABWIN] + (size_t)j * DM * ABN; K = DM; ld = ABN; WT = (bf16_t*)(ws + W_ABIN) + (size_t)j * PNG * DM; gk = p->in[I_ABNORM] + (size_t)j * DM;
            if (r < 1024) { nblk = 64; } else if (r < 1536) { r -= 1024; nblk = 32; c0 = 2064; r0 = 2048; } else { r -= 1536; nblk = 1; c0 = 2048; r0 = 3072; } }
        else if (r < 2064) { r -= 1552; W = p->in[I_ABWOUT] + (size_t)j * DM * DM; K = DM; ld = DM; nblk = 32; WT = (bf16_t*)(ws + W_ABOUT) + (size_t)j * DM * DM; }
        else if (r < 2400) { r -= 2064; W = p->in[I_CWIN] + (size_t)j * DM * CIN; K = DM; ld = CIN; nblk = 21; WT = (bf16_t*)(ws + W_CIN) + (size_t)j * CINP * DM; gk = p->in[I_CNORM] + (size_t)j * DM; }
        else if (r < 2688) { r -= 2400; W = p->in[I_CWUQ] + (size_t)j * QL * NQ; K = QL; ld = NQ; nblk = 48; WT = (bf16_t*)(ws + W_CUQ) + (size_t)j * NQ * QL; }
        else if (r < 2944) { r -= 2688; W = p->in[I_CWUKV] + (size_t)j * KVL * NKV; K = KVL; ld = NKV; nblk = 64; WT = (bf16_t*)(ws + W_CUKV) + (size_t)j * NKV * KVL; }
        else { r -= 2944; W = p->in[I_CWOUT] + (size_t)j * DM * DM; K = DM; ld = DM; nblk = 32; WT = (bf16_t*)(ws + W_COUT) + (size_t)j * DM * DM; }
    }
    const int kb = r / nblk, nb = r % nblk, k0 = 64 * kb, n0 = 32 * nb;
    d.W = W + (size_t)k0 * ld + c0 + n0; d.WT = WT + (size_t)(r0 + n0) * K + k0; d.gk = gk ? gk + k0 : nullptr; d.K = K; d.ld = ld;
    return d;
}
__device__ __forceinline__ void tload(const TDesc& d, int lane, float (&v)[32], f32x4 (&g)[2]) {
#pragma unroll
    for (int i = 0; i < 32; ++i) v[i] = __builtin_nontemporal_load(d.W + (size_t)(2 * i + (lane >> 5)) * d.ld + (lane & 31));
    if (d.gk) { g[0] = *(const f32x4*)(d.gk + 8 * (lane & 7)); g[1] = *(const f32x4*)(d.gk + 8 * (lane & 7) + 4); }
    else { g[0] = (f32x4){1.f, 1.f, 1.f, 1.f}; g[1] = g[0]; }
}
__device__ __forceinline__ void phase_prep(const Ctx& C, PP p) {
    unsigned char* ws = p->ws;
    { LAS float* scr = (LAS float*)(C.lds + C.wave * 16384);
      const int gw = C.vcu * 8 + C.wave, NGW = C.G * 8, lane = C.lane, c = lane & 7;
      int it = gw; TDesc d; float v[32]; f32x4 g[2];
      if (it < TI_ALL) { d = tdecode(p, ws, it); tload(d, lane, v, g); }
      while (it < TI_ALL) {
          const int itn = it + NGW; TDesc dn = d; float vn[32]; f32x4 gn[2];
          if (itn < TI_ALL) { dn = tdecode(p, ws, itn); tload(dn, lane, vn, gn); }
          else {
#pragma unroll
              for (int i = 0; i < 32; ++i) vn[i] = 0.f;
              gn[0] = g[0]; gn[1] = g[1]; }
#pragma unroll
          for (int i = 0; i < 32; ++i) scr[(2 * i + (lane >> 5)) * 33 + (lane & 31)] = v[i];
          LDS_WAIT(); asm volatile("" ::: "memory");
#pragma unroll
          for (int j = 0; j < 4; ++j) { const int n = (lane >> 3) + 8 * j; const LAS float* sp = scr + (8 * c) * 33 + n;
              u32x4 o; o.x = pk2(sp[0 * 33] * g[0].x, sp[1 * 33] * g[0].y); o.y = pk2(sp[2 * 33] * g[0].z, sp[3 * 33] * g[0].w);
              o.z = pk2(sp[4 * 33] * g[1].x, sp[5 * 33] * g[1].y); o.w = pk2(sp[6 * 33] * g[1].z, sp[7 * 33] * g[1].w);
              *(u32x4*)(d.WT + (size_t)n * d.K + 8 * c) = o; }
          LDS_WAIT(); asm volatile("" ::: "memory");
          d = dn; g[0] = gn[0]; g[1] = gn[1];
#pragma unroll
          for (int i = 0; i < 32; ++i) v[i] = vn[i];
          it = itn; } }
    const int gt = C.vcu * NTHR + C.tid, NGT = C.G * NTHR;
    for (int i = gt; i < 2 * 12288; i += NGT) { const int j = i / 12288, r = i % 12288;
        unsigned zz; asm volatile("v_mov_b32 %0, 0" : "=v"(zz));
        *(u32x4*)((bf16_t*)(ws + W_CIN) + (size_t)j * CINP * DM + (size_t)CIN * DM + (size_t)r * 8) = (u32x4){zz, zz, zz, zz}; }
    { const int gw = C.vcu * 8 + C.wave, NGW = C.G * 8, lane = C.lane; const float* x = p->in[I_X]; bf16_t* xb = (bf16_t*)p->out; float* ss0 = (float*)(ws + WS_SS);
      for (int r = gw; r < TOK; r += 2 * NGW) { const int r2 = (r + NGW < TOK) ? r + NGW : r;
          const f32x4* xr = (const f32x4*)(x + (size_t)r * DM) + lane; const f32x4* xr2 = (const f32x4*)(x + (size_t)r2 * DM) + lane; f32x4 v[4], u[4]; float sq = 0.f, sq2 = 0.f;
#pragma unroll
          for (int jj = 0; jj < 4; ++jj) { v[jj] = __builtin_nontemporal_load(xr + 64 * jj); u[jj] = __builtin_nontemporal_load(xr2 + 64 * jj); }
#pragma unroll
          for (int jj = 0; jj < 4; ++jj) { sq += (v[jj].x * v[jj].x + v[jj].y * v[jj].y) + (v[jj].z * v[jj].z + v[jj].w * v[jj].w); sq2 += (u[jj].x * u[jj].x + u[jj].y * u[jj].y) + (u[jj].z * u[jj].z + u[jj].w * u[jj].w); }
          unsigned long long* o8 = (unsigned long long*)(xb + (size_t)r * DM) + lane; unsigned long long* o82 = (unsigned long long*)(xb + (size_t)r2 * DM) + lane;
#pragma unroll
          for (int jj = 0; jj < 4; ++jj) { o8[64 * jj] = (unsigned long long)pk2(v[jj].x, v[jj].y) | ((unsigned long long)pk2(v[jj].z, v[jj].w) << 32);
              o82[64 * jj] = (unsigned long long)pk2(u[jj].x, u[jj].y) | ((unsigned long long)pk2(u[jj].z, u[jj].w) << 32); }
          sq = wave_sum(sq); sq2 = wave_sum(sq2);
          if (lane < 16) { ss0[(size_t)r * 16 + lane] = (lane == 0) ? sq : 0.f; ss0[(size_t)r2 * 16 + lane] = (lane == 0) ? sq2 : 0.f; } } }
    const int* pos = (const int*)p->in[I_POS]; float* rope = (float*)(ws + WS_ROPE);
    for (int i = gt; i < TOK * 16; i += NGT) { const int t = i >> 4, j = i & 15;
        const float freq = __builtin_amdgcn_exp2f(-(float)j * 0.8304820237218406f);
        const float ang = (float)pos[t] * freq;
        const float kq = rintf(ang * 0.15915494309189535f);
        float rr = fmaf(-kq, 6.28125f, ang); rr = fmaf(-kq, 0.0019353071795864769f, rr);
        const float fr = rr * 0.15915494309189535f;
        rope[(size_t)t * 32 + j] = __builtin_amdgcn_cosf(fr); rope[(size_t)t * 32 + 16 + j] = __builtin_amdgcn_sinf(fr); }
}

__device__ __forceinline__ void phase_norm(const Ctx& C, const float* src, const float* g, bf16_t* dst, const float* wg_src  , const float* gate_b, float* gates) {
    LAS float* wgt = (LAS float*)C.lds;
    if (wg_src) {
        for (int i = C.tid; i < 1024 * 4; i += NTHR) { const int c = i >> 2, q = i & 3; const f32x4 v = *(const f32x4*)(wg_src + (size_t)c * ABN + 2048 + q * 4);
            wgt[(q * 4 + 0) * 1024 + c] = v.x; wgt[(q * 4 + 1) * 1024 + c] = v.y; wgt[(q * 4 + 2) * 1024 + c] = v.z; wgt[(q * 4 + 3) * 1024 + c] = v.w; }
        __syncthreads();
    }
    const int gw = C.vcu * 8 + C.wave, NGW = C.G * 8, lane = C.lane;
    f32x4 gv[4];
#pragma unroll
    for (int j = 0; j < 4; ++j) gv[j] = *(const f32x4*)(g + 4 * lane + 256 * j);
    for (int r = gw; r < TOK; r += NGW) {
        const f32x4* xr = (const f32x4*)(src + (size_t)r * DM) + lane;
        f32x4 v[4]; float s = 0.f;
#pragma unroll
        for (int j = 0; j < 4; ++j) { v[j] = xr[64 * j]; s += (v[j].x * v[j].x + v[j].y * v[j].y) + (v[j].z * v[j].z + v[j].w * v[j].w); }
        const float rs = 1.f / sqrtf(wave_sum(s) * (1.f / DM) + EPS);
        unsigned long long* o8 = (unsigned long long*)(dst + (size_t)r * DM) + lane;
#pragma unroll
        for (int j = 0; j < 4; ++j) { v[j] = v[j] * rs * gv[j]; o8[64 * j] = (unsigned long long)pk2(v[j].x, v[j].y) | ((unsigned long long)pk2(v[j].z, v[j].w) << 32); }
        if (wg_src) {
            float acc[16];
#pragma unroll
            for (int q = 0; q < 16; ++q) { float a = 0.f;
#pragma unroll
                for (int j = 0; j < 4; ++j) { const f32x4 w = *(const LAS f32x4*)(wgt + q * 1024 + 4 * lane + 256 * j); a += (v[j].x * w.x + v[j].y * w.y) + (v[j].z * w.z + v[j].w * w.w); }
                acc[q] = a; }
            float a8[8], a4[4], a2[2], a1;
            { const bool up = (lane & 32) != 0;
#pragma unroll
              for (int i = 0; i < 8; ++i) { const float send = up ? acc[i] : acc[i + 8], keep = up ? acc[i + 8] : acc[i]; a8[i] = keep + __shfl_xor(send, 32); } }
            { const bool up = (lane & 16) != 0;
#pragma unroll
              for (int i = 0; i < 4; ++i) { const float send = up ? a8[i] : a8[i + 4], keep = up ? a8[i + 4] : a8[i]; a4[i] = keep + __shfl_xor(send, 16); } }
            { const bool up = (lane & 8) != 0;
#pragma unroll
              for (int i = 0; i < 2; ++i) { const float send = up ? a4[i] : a4[i + 2], keep = up ? a4[i + 2] : a4[i]; a2[i] = keep + __shfl_xor(send, 8); } }
            { const bool up = (lane & 4) != 0; const float send = up ? a2[0] : a2[1], keep = up ? a2[1] : a2[0]; a1 = keep + __shfl_xor(send, 4); }
            a1 += __shfl_xor(a1, 1); a1 += __shfl_xor(a1, 2);
            if ((lane & 3) == 0) { const int q = lane >> 2; float x = a1 + gate_b[q];
                if ((q >> 2) & 1) x = fminf(x, 0.f) - log1pf(__expf(-fabsf(x)));
                gates[(size_t)r * 16 + q] = x; }
        }
    }
}
__device__ __forceinline__ void phase_final_norm(const Ctx& C, const bf16_t* xb, float* out, const float* g) {
    const int gw = C.vcu * 8 + C.wave, NGW = C.G * 8, lane = C.lane;
    f32x4 gv[4];
#pragma unroll
    for (int j = 0; j < 4; ++j) gv[j] = *(const f32x4*)(g + 4 * lane + 256 * j);
    constexpr int RB = 4;
    for (int r0 = gw; r0 < TOK; r0 += RB * NGW) {
        u32x2 w[RB][4]; int rr[RB];
#pragma unroll
        for (int u = 0; u < RB; ++u) { const int r = (r0 + u * NGW < TOK) ? r0 + u * NGW : r0; rr[u] = r; const u32x2* xr = (const u32x2*)(xb + (size_t)r * DM) + lane;
#pragma unroll
            for (int j = 0; j < 4; ++j) w[u][j] = __builtin_nontemporal_load(xr + 64 * j); }
#pragma unroll
        for (int u = 0; u < RB; ++u) { f32x4 v[4]; float s = 0.f;
#pragma unroll
            for (int j = 0; j < 4; ++j) { v[j] = (f32x4){bflo(w[u][j].x), bfhi(w[u][j].x), bflo(w[u][j].y), bfhi(w[u][j].y)}; s += (v[j].x * v[j].x + v[j].y * v[j].y) + (v[j].z * v[j].z + v[j].w * v[j].w); }
            const float rs = 1.f / sqrtf(wave_sum(s) * (1.f / DM) + EPS);
            f32x4* o = (f32x4*)(out + (size_t)rr[u] * DM) + lane;
#pragma unroll
            for (int j = 0; j < 4; ++j) o[64 * j] = v[j] * rs * gv[j]; }
    }
}
__device__ __forceinline__ void phase_c2b(const Ctx& C, const bf16_t* cqkv, const float* qg, const float* kvg, const float* rope, bf16_t* cqn, bf16_t* ckvn, bf16_t* kr) {
    const int gw = C.vcu * 8 + C.wave, NGW = C.G * 8, lane = C.lane;
    float gq[6], gk[4];
#pragma unroll
    for (int i = 0; i < 6; ++i) gq[i] = qg[lane * 6 + i];
#pragma unroll
    for (int i = 0; i < 4; ++i) gk[i] = kvg[lane * 4 + i];
    constexpr int RB = 4;
    for (int r0 = gw; r0 < TOK; r0 += RB * NGW) {
        unsigned w0[RB], w1[RB], w2[RB]; u32x2 kw[RB]; bf16_t x1b[RB], x2b[RB]; float cs[RB], sn[RB]; int rr[RB];
#pragma unroll
        for (int u = 0; u < RB; ++u) { const int r = (r0 + u * NGW < TOK) ? r0 + u * NGW : r0; rr[u] = r;
            const bf16_t* row = cqkv + (size_t)r * CINP; const unsigned* q32 = (const unsigned*)(row + lane * 6);
            w0[u] = __builtin_nontemporal_load(q32); w1[u] = __builtin_nontemporal_load(q32 + 1); w2[u] = __builtin_nontemporal_load(q32 + 2); kw[u] = __builtin_nontemporal_load((const u32x2*)(row + QL + lane * 4));
            x1b[u] = row[QL + KVL + (lane & 15)]; x2b[u] = row[QL + KVL + 16 + (lane & 15)];
            cs[u] = rope[(size_t)r * 32 + (lane & 15)]; sn[u] = rope[(size_t)r * 32 + 16 + (lane & 15)]; }
#pragma unroll
        for (int u = 0; u < RB; ++u) { const int r = rr[u];
            float q[6] = {bflo(w0[u]), bfhi(w0[u]), bflo(w1[u]), bfhi(w1[u]), bflo(w2[u]), bfhi(w2[u])};
            float k[4] = {bflo(kw[u].x), bfhi(kw[u].x), bflo(kw[u].y), bfhi(kw[u].y)};
            float sq = 0.f, sk = 0.f;
#pragma unroll
            for (int i = 0; i < 6; ++i) sq += q[i] * q[i];
#pragma unroll
            for (int i = 0; i < 4; ++i) sk += k[i] * k[i];
            const float rq = 1.f / sqrtf(wave_sum(sq) * (1.f / QL) + EPS), rk = 1.f / sqrtf(wave_sum(sk) * (1.f / KVL) + EPS);
            unsigned* oq = (unsigned*)(cqn + (size_t)r * QL + lane * 6);
            oq[0] = pk2(q[0] * rq * gq[0], q[1] * rq * gq[1]); oq[1] = pk2(q[2] * rq * gq[2], q[3] * rq * gq[3]); oq[2] = pk2(q[4] * rq * gq[4], q[5] * rq * gq[5]);
            u32x2 ok; ok.x = pk2(k[0] * rk * gk[0], k[1] * rk * gk[1]); ok.y = pk2(k[2] * rk * gk[2], k[3] * rk * gk[3]);
            *(u32x2*)(ckvn + (size_t)r * KVL + lane * 4) = ok;
            if (lane < 16) { const float x1 = bf2f(x1b[u]), x2 = bf2f(x2b[u]);
                kr[(size_t)r * 32 + lane] = (bf16_t)f2bf(x1 * cs[u] - x2 * sn[u]); kr[(size_t)r * 32 + 16 + lane] = (bf16_t)f2bf(x1 * sn[u] + x2 * cs[u]); } }
    }
}

constexpr int TP = 136;
constexpr int TILE_B = 128 * TP * 2;
__device__ __forceinline__ void mm128T(f32x4 (&acc)[2][4], const LAS bf16_t* A, const LAS bf16_t* B, int wr, int wc, int fr, int fq) {
#pragma unroll
    for (int kk = 0; kk < 4; ++kk) {
        bf16x8 a[2], b[4];
#pragma unroll
        for (int mt = 0; mt < 2; ++mt) a[mt] = *(const LAS bf16x8*)(A + (wr * 32 + mt * 16 + fr) * TP + kk * 32 + fq * 8);
#pragma unroll
        for (int nt = 0; nt < 4; ++nt) b[nt] = *(const LAS bf16x8*)(B + (wc * 64 + nt * 16 + fr) * TP + kk * 32 + fq * 8);
#pragma unroll
        for (int mt = 0; mt < 2; ++mt)
#pragma unroll
            for (int nt = 0; nt < 4; ++nt) acc[mt][nt] = __builtin_amdgcn_mfma_f32_16x16x32_bf16(b[nt], a[mt], acc[mt][nt], 0, 0, 0);
    }
}
__device__ __forceinline__ void zero_acc(f32x4 (&acc)[2][4]) {
#pragma unroll
    for (int mt = 0; mt < 2; ++mt)
#pragma unroll
        for (int nt = 0; nt < 4; ++nt) acc[mt][nt] = (f32x4){0.f, 0.f, 0.f, 0.f};
}
__device__ __forceinline__ void conv_load(const bf16_t* P, size_t tokbase, int l0, int col, int rg, u32x4 (&raw)[8]) {
#pragma unroll
    for (int r = 0; r < 8; ++r) { const int lp = l0 + rg * 4 - 2 + r;
        if (lp >= 0 && lp < SEQ) raw[r] = *(const u32x4*)(P + (tokbase + lp) * PN + col);
        else raw[r] = (u32x4){0u, 0u, 0u, 0u}; }
}
__device__ __forceinline__ void conv_compute(const u32x4 (&raw)[8], const float* cw, int col, float scale, float (&out)[4][8]) {
    float w[5][8];
#pragma unroll
    for (int j = 0; j < 5; ++j) { const f32x4 a = *(const f32x4*)(cw + j * 1024 + col), b = *(const f32x4*)(cw + j * 1024 + col + 4);
        w[j][0] = a.x; w[j][1] = a.y; w[j][2] = a.z; w[j][3] = a.w; w[j][4] = b.x; w[j][5] = b.y; w[j][6] = b.z; w[j][7] = b.w; }
#pragma unroll
    for (int i = 0; i < 4; ++i)
#pragma unroll
        for (int e = 0; e < 8; ++e) out[i][e] = 0.f;
#pragma unroll
    for (int r = 0; r < 8; ++r) { float x[8]; unpack8(raw[r], x);
#pragma unroll
        for (int i = 0; i < 4; ++i) { const int j = r - i; if (j >= 0 && j < 5) {
#pragma unroll
            for (int e = 0; e < 8; ++e) out[i][e] += w[j][e] * x[e]; } }
    }
#pragma unroll
    for (int i = 0; i < 4; ++i)
#pragma unroll
        for (int e = 0; e < 8; ++e) { const float v = out[i][e]; out[i][e] = v * __builtin_amdgcn_rcpf(1.f + __expf(-v)) * scale; }
}
__device__ __forceinline__ void gate_scan(const float* G  , int h, int d, int lane, LAS float* a_out, LAS float* b_out, LAS float* cm_out, float& gtot, float& amax) {
    const int i0 = 2 * lane, t0 = d ? 127 - i0 : i0, t1 = d ? 126 - i0 : i0 + 1;
    const float li0 = G[t0 * 16 + d * 8 + h], lf0 = G[t0 * 16 + d * 8 + 4 + h], li1 = G[t1 * 16 + d * 8 + h], lf1 = G[t1 * 16 + d * 8 + 4 + h];
    const float s = lf0 + lf1; float incl = s;
#pragma unroll
    for (int off = 1; off < 64; off <<= 1) { const float v = __shfl_up(incl, off); if (lane >= off) incl += v; }
    const float excl = incl - s, b0 = excl + lf0, b1 = incl;
    const float a0 = li0 - b0, a1 = li1 - b1;
    float mx = fmaxf(a0, a1);
#pragma unroll
    for (int off = 1; off < 64; off <<= 1) { const float v = __shfl_up(mx, off); if (lane >= off) mx = fmaxf(mx, v); }
    float pm = __shfl_up(mx, 1); if (lane == 0) pm = -3.0e38f;
    a_out[t0] = a0; a_out[t1] = a1; b_out[t0] = b0; b_out[t1] = b1; cm_out[t0] = fmaxf(pm, a0); cm_out[t1] = mx;
    gtot = __shfl(incl, 63); amax = __shfl(mx, 63);
}

constexpr int SM_OFF = 4 * TILE_B;
__device__ __forceinline__ void phase_m1_sgu(const Ctx& C, PP p, int j) {
    unsigned char* ws = p->ws;
    const bf16_t* P = (const bf16_t*)(ws + WS_BIG);
    const float* gates = (const float*)(ws + WS_GATES);
    bf16_t* cloc = (bf16_t*)(ws + WS_CLOC); float* nloc = (float*)(ws + WS_NLOC); float* stat = (float*)(ws + WS_STAT);
    bf16_t* hab = (bf16_t*)(ws + WS_HAB);
    const float* cw = p->in[I_ABCONV] + (size_t)j * 5 * 1024;
    LAS bf16_t* VT = (LAS bf16_t*)(C.lds); LAS bf16_t* KF = (LAS bf16_t*)(C.lds + TILE_B); LAS bf16_t* KB = (LAS bf16_t*)(C.lds + 2 * TILE_B);
    LAS float* sm = (LAS float*)(C.lds + SM_OFF);
    const int tid = C.tid, lane = C.lane, wid = C.wave, wr = wid >> 1, wc = wid & 1, fr = lane & 15, fq = lane >> 4;
    const int cc = tid & 15, rg = tid >> 4;
    for (int it = C.vcu; it < 2048; it += C.G) {
        __syncthreads();
        if (it < 1024) {
            const int b = it >> 7, h = (it >> 5) & 3, pc = it & 31; const size_t tokbase = (size_t)b * SEQ; const int l0 = pc * 128;
            u32x4 kraw[8], vraw[4];
            conv_load(P, tokbase, l0, 512 + h * 128 + cc * 8, rg, kraw);
#pragma unroll
            for (int i = 0; i < 4; ++i) vraw[i] = *(const u32x4*)(P + (tokbase + l0 + rg * 4 + i) * PN + 1024 + h * 128 + cc * 8);
            if (wid < 2) { float gt, am; gate_scan(gates + (tokbase + l0) * 16, h, wid, lane, sm + wid * 384, sm + wid * 384 + 128, sm + wid * 384 + 256, gt, am);
                const int i0 = 2 * lane, t0 = wid ? 127 - i0 : i0, t1 = wid ? 126 - i0 : i0 + 1;
                LDS_WAIT();
                sm[768 + wid * 128 + t0] = __expf(sm[wid * 384 + t0] - am); sm[768 + wid * 128 + t1] = __expf(sm[wid * 384 + t1] - am);
                if (lane == 0) { const int sidx = ((b * 4 + h) * 2 + wid) * 32 + pc; stat[sidx * 2] = gt; stat[sidx * 2 + 1] = am; } }
            __syncthreads();
            { float k[4][8]; conv_compute(kraw, cw, 512 + h * 128 + cc * 8, 1.f, k);
              float wf[4], wb[4];
#pragma unroll
              for (int i = 0; i < 4; ++i) { wf[i] = sm[768 + rg * 4 + i]; wb[i] = sm[896 + rg * 4 + i]; }
#pragma unroll
              for (int e = 0; e < 8; ++e) { u32x2 a, bb; a.x = pk2(k[0][e] * wf[0], k[1][e] * wf[1]); a.y = pk2(k[2][e] * wf[2], k[3][e] * wf[3]);
                  bb.x = pk2(k[0][e] * wb[0], k[1][e] * wb[1]); bb.y = pk2(k[2][e] * wb[2], k[3][e] * wb[3]);
                  *(LAS u32x2*)(KF + (cc * 8 + e) * TP + rg * 4) = a; *(LAS u32x2*)(KB + (cc * 8 + e) * TP + rg * 4) = bb; } }
            { float v[4][8];
#pragma unroll
              for (int i = 0; i < 4; ++i) unpack8(vraw[i], v[i]);
#pragma unroll
              for (int e = 0; e < 8; ++e) { u32x2 a; a.x = pk2(v[0][e], v[1][e]); a.y = pk2(v[2][e], v[3][e]); *(LAS u32x2*)(VT + (cc * 8 + e) * TP + rg * 4) = a; } }
            __syncthreads();
#pragma unroll 1
            for (int d = 0; d < 2; ++d) {
                f32x4 acc[2][4]; zero_acc(acc);
                mm128T(acc, VT, d ? KB : KF, wr, wc, fr, fq);
                bf16_t* ct = cloc + ((size_t)(((b * 4 + h) * 2 + d) * 32 + pc)) * 16384;
#pragma unroll
                for (int mt = 0; mt < 2; ++mt)
#pragma unroll
                    for (int nt = 0; nt < 4; ++nt) { u32x2 w; w.x = pk2(acc[mt][nt][0], acc[mt][nt][1]); w.y = pk2(acc[mt][nt][2], acc[mt][nt][3]);
                        *(u32x2*)(ct + (wr * 32 + mt * 16 + fr) * 128 + wc * 64 + nt * 16 + fq * 4) = w; }
            }
            if (tid < 256) { const int d = tid >> 7, dd = tid & 127; const LAS bf16_t* row = (d ? KB : KF) + dd * TP; float s = 0.f;
#pragma unroll
                for (int q = 0; q < 16; ++q) { const u32x4 w = *(const LAS u32x4*)(row + q * 8); float x[8]; unpack8(w, x);
#pragma unroll
                    for (int e = 0; e < 8; ++e) s += x[e]; }
                nloc[((size_t)(((b * 4 + h) * 2 + d) * 32 + pc)) * 128 + dd] = s; }
        } else {
            const int it2 = it - 1024, b = it2 >> 7, n = (it2 >> 2) & 31, gi = it2 & 3; const size_t row0 = (size_t)b * SEQ + n * 128;
            LAS bf16_t* AW = KF; LAS bf16_t* VBT = VT;
            const int r = tid >> 2, q = tid & 3;
            { const float* wsrc = p->in[I_ABWS] + ((size_t)(j * 4 + gi) * 128 + r) * 128 + q * 32;
#pragma unroll
              for (int c8 = 0; c8 < 4; ++c8) { const f32x4 a = *(const f32x4*)(wsrc + c8 * 8), bb = *(const f32x4*)(wsrc + c8 * 8 + 4);
                  u32x4 w; w.x = pk2(a.x, a.y); w.y = pk2(a.z, a.w); w.z = pk2(bb.x, bb.y); w.w = pk2(bb.z, bb.w);
                  *(LAS u32x4*)(AW + r * TP + q * 32 + c8 * 8) = w; } }
            { const bf16_t* vsrc = P + (row0 + r) * PN + 2560 + gi * 128 + q * 32; float x[32]; float ss = 0.f;
#pragma unroll
              for (int c8 = 0; c8 < 4; ++c8) { const u32x4 w = *(const u32x4*)(vsrc + c8 * 8); unpack8(w, x + c8 * 8); }
#pragma unroll
              for (int e = 0; e < 32; ++e) ss += x[e] * x[e];
              ss += __shfl_xor(ss, 1); ss += __shfl_xor(ss, 2);
              const float rs = 1.f / sqrtf(ss * (1.f / 128.f) + EPS);
              const float* vg = p->in[I_ABVG] + (size_t)j * 512 + gi * 128 + q * 32;
#pragma unroll
              for (int e = 0; e < 32; ++e) VBT[(q * 32 + e) * TP + r] = (bf16_t)f2bf(x[e] * rs * vg[e]); }
            u32x2 uraw[2][4];
#pragma unroll
            for (int mt = 0; mt < 2; ++mt)
#pragma unroll
                for (int nt = 0; nt < 4; ++nt) uraw[mt][nt] = *(const u32x2*)(P + (row0 + wr * 32 + mt * 16 + fr) * PN + 2048 + gi * 128 + wc * 64 + nt * 16 + fq * 4);
            __syncthreads();
            f32x4 acc[2][4]; zero_acc(acc);
            mm128T(acc, AW, VBT, wr, wc, fr, fq);
            const float* bs = p->in[I_ABBS] + (size_t)(j * 4 + gi) * 128;
#pragma unroll
            for (int mt = 0; mt < 2; ++mt) { const int t = wr * 32 + mt * 16 + fr; const float bt = bs[t];
#pragma unroll
                for (int nt = 0; nt < 4; ++nt) { const int c = wc * 64 + nt * 16 + fq * 4;
                    const u32x2 uw = uraw[mt][nt];
                    u32x2 o; o.x = pk2(bflo(uw.x) * (acc[mt][nt][0] + bt), bfhi(uw.x) * (acc[mt][nt][1] + bt)); o.y = pk2(bflo(uw.y) * (acc[mt][nt][2] + bt), bfhi(uw.y) * (acc[mt][nt][3] + bt));
                    *(u32x2*)(hab + (row0 + t) * DM + 512 + gi * 128 + c) = o; } }
        }
    }
}
__device__ __forceinline__ void phase_m2(const Ctx& C, PP p) {
    unsigned char* ws = p->ws;
    bf16_t* cloc = (bf16_t*)(ws + WS_CLOC); float* nloc = (float*)(ws + WS_NLOC); const float* stat = (const float*)(ws + WS_STAT); float* mprev = (float*)(ws + WS_MPREV);
    const int gt = C.vcu * NTHR + C.tid, NGT = C.G * NTHR;
    for (int idx = gt; idx < 64 * 2048; idx += NGT) {
        const int seq = idx >> 11, slot = idx & 2047, d = seq & 1; const bool has_n = slot < 32;
        bf16_t* base = cloc + (size_t)seq * 32 * 16384 + slot * 8; float* nbase = nloc + (size_t)seq * 32 * 128 + (slot & 31) * 4;
        float st[8]; f32x4 nst = (f32x4){0.f, 0.f, 0.f, 0.f}; float m = 0.f;
#pragma unroll
        for (int e = 0; e < 8; ++e) st[e] = 0.f;
        u32x4 cur[8], nxt[8]; f32x4 ncur[8], nnxt[8];
#pragma unroll
        for (int u = 0; u < 8; ++u) { const int pc = d ? 31 - u : u; cur[u] = *(const u32x4*)(base + (size_t)pc * 16384); ncur[u] = has_n ? *(const f32x4*)(nbase + (size_t)pc * 128) : nst; }
#pragma unroll 1
        for (int c0 = 0; c0 < 32; c0 += 8) {
            if (c0 + 8 < 32) {
#pragma unroll
                for (int u = 0; u < 8; ++u) { const int pc = d ? 31 - (c0 + 8 + u) : c0 + 8 + u; nxt[u] = *(const u32x4*)(base + (size_t)pc * 16384); nnxt[u] = has_n ? *(const f32x4*)(nbase + (size_t)pc * 128) : nst; }
            }
#pragma unroll
            for (int u = 0; u < 8; ++u) { const int pc = d ? 31 - (c0 + u) : c0 + u;
                const float g = stat[(seq * 32 + pc) * 2], am = stat[(seq * 32 + pc) * 2 + 1];
                u32x4 w; w.x = pk2(st[0], st[1]); w.y = pk2(st[2], st[3]); w.z = pk2(st[4], st[5]); w.w = pk2(st[6], st[7]);
                *(u32x4*)(base + (size_t)pc * 16384) = w;
                if (has_n) *(f32x4*)(nbase + (size_t)pc * 128) = nst;
                if (slot == 0) mprev[seq * 32 + pc] = m;
                const float M = fmaxf(m, am), decay = __expf(m - M), sc = __expf(am - M);
                float x[8]; unpack8(cur[u], x);
#pragma unroll
                for (int e = 0; e < 8; ++e) st[e] = st[e] * decay + x[e] * sc;
                nst = nst * decay + ncur[u] * sc;
                m = g + M; }
#pragma unroll
            for (int u = 0; u < 8; ++u) { cur[u] = nxt[u]; ncur[u] = nnxt[u]; }
        }
    }
}
__device__ __forceinline__ void phase_m3(const Ctx& C, PP p, int j) {
    unsigned char* ws = p->ws;
    const bf16_t* P = (const bf16_t*)(ws + WS_BIG);
    const float* gates = (const float*)(ws + WS_GATES);
    const bf16_t* cprev = (const bf16_t*)(ws + WS_CLOC); const float* nprev = (const float*)(ws + WS_NLOC); const float* mprev = (const float*)(ws + WS_MPREV);
    bf16_t* hab = (bf16_t*)(ws + WS_HAB);
    const float* cw = p->in[I_ABCONV] + (size_t)j * 5 * 1024;
    const float* hg = p->in[I_ABHG] + (size_t)j * 512;
    LAS bf16_t* QS = (LAS bf16_t*)(C.lds); LAS bf16_t* KS = (LAS bf16_t*)(C.lds + TILE_B); LAS bf16_t* VT = (LAS bf16_t*)(C.lds + 2 * TILE_B); LAS bf16_t* CT = (LAS bf16_t*)(C.lds + 3 * TILE_B);
    LAS float* sm = (LAS float*)(C.lds + SM_OFF);
    const int tid = C.tid, lane = C.lane, wid = C.wave, wr = wid >> 1, wc = wid & 1, fr = lane & 15, fq = lane >> 4;
    const int cc = tid & 15, rg = tid >> 4;
    for (int it = C.vcu; it < 1024; it += C.G) {
        const int b = it >> 7, h = (it >> 5) & 3, pc = it & 31; const size_t tokbase = (size_t)b * SEQ; const int l0 = pc * 128;
        __syncthreads();
        u32x4 ctr[4];
        { const bf16_t* src = cprev + (size_t)(((b * 4 + h) * 2 + 0) * 32 + pc) * 16384 + (tid >> 2) * 128 + (tid & 3) * 32;
#pragma unroll
          for (int c8 = 0; c8 < 4; ++c8) ctr[c8] = *(const u32x4*)(src + c8 * 8); }
        u32x4 qraw[8], kraw[8], vraw[4];
        conv_load(P, tokbase, l0, h * 128 + cc * 8, rg, qraw);
#pragma unroll
        for (int i = 0; i < 4; ++i) vraw[i] = *(const u32x4*)(P + (tokbase + l0 + rg * 4 + i) * PN + 1024 + h * 128 + cc * 8);
        if (wid < 2) { float gt, am; gate_scan(gates + (tokbase + l0) * 16, h, wid, lane, sm + wid * 512, sm + wid * 512 + 128, sm + wid * 512 + 256, gt, am);
            if (lane == 0) sm[2176 + wid] = mprev[((b * 4 + h) * 2 + wid) * 32 + pc]; }
        { float x[4][8]; conv_compute(qraw, cw, h * 128 + cc * 8, 0.08838834764831845f, x);
#pragma unroll
          for (int i = 0; i < 4; ++i) { u32x4 w; w.x = pk2(x[i][0], x[i][1]); w.y = pk2(x[i][2], x[i][3]); w.z = pk2(x[i][4], x[i][5]); w.w = pk2(x[i][6], x[i][7]); *(LAS u32x4*)(QS + (rg * 4 + i) * TP + cc * 8) = w; } }
        conv_load(P, tokbase, l0, 512 + h * 128 + cc * 8, rg, kraw);
        { float x[4][8]; conv_compute(kraw, cw, 512 + h * 128 + cc * 8, 1.f, x);
#pragma unroll
          for (int i = 0; i < 4; ++i) { u32x4 w; w.x = pk2(x[i][0], x[i][1]); w.y = pk2(x[i][2], x[i][3]); w.z = pk2(x[i][4], x[i][5]); w.w = pk2(x[i][6], x[i][7]); *(LAS u32x4*)(KS + (rg * 4 + i) * TP + cc * 8) = w; } }
        { float v[4][8];
#pragma unroll
          for (int i = 0; i < 4; ++i) unpack8(vraw[i], v[i]);
#pragma unroll
          for (int e = 0; e < 8; ++e) { u32x2 a; a.x = pk2(v[0][e], v[1][e]); a.y = pk2(v[2][e], v[3][e]); *(LAS u32x2*)(VT + (cc * 8 + e) * TP + rg * 4) = a; } }
        __syncthreads();
        f32x4 sacc[2][4]; zero_acc(sacc);
        mm128T(sacc, QS, KS, wr, wc, fr, fq);
        f32x4 hsum[2][4]; zero_acc(hsum);
#pragma unroll 1
        for (int d = 0; d < 2; ++d) {
            __syncthreads();
            const size_t sidx = (size_t)(((b * 4 + h) * 2 + d) * 32 + pc);
            { const int r = tid >> 2, q = tid & 3;
#pragma unroll
              for (int c8 = 0; c8 < 4; ++c8) *(LAS u32x4*)(CT + r * TP + q * 32 + c8 * 8) = ctr[c8];
              if (d == 0) { const bf16_t* src = cprev + (sidx + 32) * 16384 + r * 128 + q * 32;
#pragma unroll
                  for (int c8 = 0; c8 < 4; ++c8) ctr[c8] = *(const u32x4*)(src + c8 * 8); } }
            if (tid < 128) sm[1024 + tid] = nprev[sidx * 128 + tid];
            const float mp = sm[2176 + d];
            LAS float* av = sm + d * 512; LAS float* bv = av + 128; LAS float* cm = av + 256;
#pragma unroll
            for (int mt = 0; mt < 2; ++mt) { const int t = wr * 32 + mt * 16 + fr; const float Mt = fmaxf(mp, cm[t]); float rsum = 0.f;
#pragma unroll
                for (int nt = 0; nt < 4; ++nt) { const int s0 = wc * 64 + nt * 16 + fq * 4; float pv[4];
#pragma unroll
                    for (int jj = 0; jj < 4; ++jj) { const int s = s0 + jj; const bool ok = d ? (s >= t) : (s <= t);
                        const float wgt = ok ? __expf(av[s] - Mt) : 0.f; pv[jj] = sacc[mt][nt][jj] * wgt; rsum += pv[jj]; }
                    u32x2 o; o.x = pk2(pv[0], pv[1]); o.y = pk2(pv[2], pv[3]); *(LAS u32x2*)(KS + t * TP + s0) = o; }
                rsum = rows4_sum(rsum);
                if (fq == 0) sm[1152 + wc * 128 + t] = rsum; }
            __syncthreads();
            { const int t = tid & 127, part = tid >> 7; float s = 0.f;
#pragma unroll
              for (int q = 0; q < 4; ++q) { const u32x4 w = *(const LAS u32x4*)(QS + t * TP + part * 32 + q * 8); float x[8]; unpack8(w, x);
#pragma unroll
                  for (int e = 0; e < 8; ++e) s += x[e] * sm[1024 + part * 32 + q * 8 + e]; }
              sm[1408 + part * 128 + t] = s; }
            f32x4 a1[2][4], a2[2][4]; zero_acc(a1); zero_acc(a2);
            mm128T(a1, KS, VT, wr, wc, fr, fq);
            mm128T(a2, QS, CT, wr, wc, fr, fq);
            __syncthreads();
#pragma unroll
            for (int mt = 0; mt < 2; ++mt) { const int t = wr * 32 + mt * 16 + fr; const float Mt = fmaxf(mp, cm[t]);
                const float inter = __expf(mp - Mt);
                const float qn = (sm[1408 + t] + sm[1536 + t]) + (sm[1664 + t] + sm[1792 + t]);
                const float den = sm[1152 + t] + sm[1280 + t] + inter * qn;
                const float dn = fmaxf(fabsf(den), __expf(-(bv[t] + Mt)));
                const float inv = 1.f / dn;
#pragma unroll
                for (int nt = 0; nt < 4; ++nt) hsum[mt][nt] += (a1[mt][nt] + a2[mt][nt] * inter) * inv; }
        }
#pragma unroll
        for (int mt = 0; mt < 2; ++mt) { const int t = wr * 32 + mt * 16 + fr; float ss = 0.f;
#pragma unroll
            for (int nt = 0; nt < 4; ++nt) ss += (hsum[mt][nt][0] * hsum[mt][nt][0] + hsum[mt][nt][1] * hsum[mt][nt][1]) + (hsum[mt][nt][2] * hsum[mt][nt][2] + hsum[mt][nt][3] * hsum[mt][nt][3]);
            ss = rows4_sum(ss);
            if (fq == 0) sm[1920 + wc * 128 + t] = ss; }
        u32x2 oraw[2][4];
#pragma unroll
        for (int mt = 0; mt < 2; ++mt)
#pragma unroll
            for (int nt = 0; nt < 4; ++nt) oraw[mt][nt] = *(const u32x2*)(P + (tokbase + l0 + wr * 32 + mt * 16 + fr) * PN + 1536 + h * 128 + wc * 64 + nt * 16 + fq * 4);
        __syncthreads();
#pragma unroll
        for (int mt = 0; mt < 2; ++mt) { const int t = wr * 32 + mt * 16 + fr; const float rs = 1.f / sqrtf((sm[1920 + t] + sm[2048 + t]) * (1.f / 128.f) + EPS);
            const size_t row = tokbase + l0 + t;
#pragma unroll
            for (int nt = 0; nt < 4; ++nt) { const int e = wc * 64 + nt * 16 + fq * 4;
                const f32x4 g4 = *(const f32x4*)(hg + h * 128 + e);
                const u32x2 ow = oraw[mt][nt];
                const float o0 = bflo(ow.x), o1 = bfhi(ow.x), o2 = bflo(ow.y), o3 = bfhi(ow.y);
                const float y0 = hsum[mt][nt][0] * rs * g4.x * __builtin_amdgcn_rcpf(1.f + __expf(-o0));
                const float y1 = hsum[mt][nt][1] * rs * g4.y * __builtin_amdgcn_rcpf(1.f + __expf(-o1));
                const float y2 = hsum[mt][nt][2] * rs * g4.z * __builtin_amdgcn_rcpf(1.f + __expf(-o2));
                const float y3 = hsum[mt][nt][3] * rs * g4.w * __builtin_amdgcn_rcpf(1.f + __expf(-o3));
                u32x2 o; o.x = pk2(y0, y1); o.y = pk2(y2, y3);
                *(u32x2*)(hab + row * DM + h * 128 + e) = o; } }
    }
}

namespace att {
constexpr int KVBLK = 64, QBLK = 32, NW = 8;
constexpr float SCALE = 0.10206207261596575f;
constexpr float THR = 8.f;
constexpr int SHM_V = KVBLK * 128 * 2, SHM_K = KVBLK * 128 * 2;
#define KSWZ(row, colB) ((row) * 256 + ((colB) ^ (((row) & 7) << 4)))
#define SBAR() __builtin_amdgcn_sched_barrier(0)
__device__ __forceinline__ int crow(int r, int hi) { return (r & 3) + 8 * (r >> 2) + 4 * hi; }
__device__ __forceinline__ void partialSM(f32x16& p0, f32x16& p1, float& m_reg, float& mn, float& alpha) {
    constexpr float Cc = SCALE * 1.4426950408889634f;
    float pmax = p0[0];
#pragma unroll
    for (int r = 1; r < 16; ++r) pmax = fmaxf(pmax, p0[r]);
#pragma unroll
    for (int r = 0; r < 16; ++r) pmax = fmaxf(pmax, p1[r]);
    { auto rr = __builtin_amdgcn_permlane32_swap(__float_as_uint(pmax), __float_as_uint(pmax), false, false);
      pmax = fmaxf(__uint_as_float(rr[0]), __uint_as_float(rr[1])); }
    if (__builtin_expect(__all(pmax - m_reg <= THR / SCALE), 1)) { mn = m_reg; alpha = 1.f; }
    else { mn = fmaxf(m_reg, pmax); alpha = __builtin_amdgcn_exp2f((m_reg - mn) * Cc); m_reg = mn; }
    const float mnC = -mn * Cc;
    { typedef float f32x2 __attribute__((ext_vector_type(2))); const f32x2 c2 = {Cc, Cc}, m2 = {mnC, mnC};
#pragma unroll
      for (int r = 0; r < 16; r += 2) { f32x2 t = {p0[r], p0[r + 1]}; t = __builtin_elementwise_fma(t, c2, m2); p0[r] = t.x; p0[r + 1] = t.y; }
#pragma unroll
      for (int r = 0; r < 16; r += 2) { f32x2 t = {p1[r], p1[r + 1]}; t = __builtin_elementwise_fma(t, c2, m2); p1[r] = t.x; p1[r + 1] = t.y; } }
#pragma unroll
    for (int r = 0; r < 16; ++r) p0[r] = __builtin_amdgcn_exp2f(p0[r]);
}
__device__ __forceinline__ void finishSM(f32x16& p0, f32x16& p1, float alpha, float& l_reg, bf16x8& pa0, bf16x8& pa1, bf16x8& pa2, bf16x8& pa3) {
#pragma unroll
    for (int r = 0; r < 16; ++r) p1[r] = __builtin_amdgcn_exp2f(p1[r]);
    float ps;
    { typedef float f32x2 __attribute__((ext_vector_type(2))); f32x2 s0 = {p0[0], p0[1]}, s1 = {p1[0], p1[1]};
#pragma unroll
      for (int r = 2; r < 16; r += 2) { s0 += (f32x2){p0[r], p0[r + 1]}; s1 += (f32x2){p1[r], p1[r + 1]}; }
      s0 += s1; ps = s0.x + s0.y; }
    { auto rr = __builtin_amdgcn_permlane32_swap(__float_as_uint(ps), __float_as_uint(ps), false, false);
      ps = __uint_as_float(rr[0]) + __uint_as_float(rr[1]); }
    l_reg = l_reg * alpha + ps;
#define PK4(P, BASE, OUT) do { unsigned a0 = cvtpk(P[BASE + 0], P[BASE + 1]), a1 = cvtpk(P[BASE + 2], P[BASE + 3]);   \
    unsigned b0 = cvtpk(P[BASE + 4], P[BASE + 5]), b1 = cvtpk(P[BASE + 6], P[BASE + 7]);                              \
    auto r0 = __builtin_amdgcn_permlane32_swap(a0, b0, false, false); auto r1 = __builtin_amdgcn_permlane32_swap(a1, b1, false, false); \
    u32x4 w = {r0[0], r1[0], r0[1], r1[1]}; OUT = *reinterpret_cast<bf16x8*>(&w); } while (0)
    PK4(p0, 0, pa0); PK4(p0, 8, pa1); PK4(p1, 0, pa2); PK4(p1, 8, pa3);
#undef PK4
}
__device__ __forceinline__ void qkt(f32x16& p0, f32x16& p1, const char* Ks, const bf16x8* qr, int r32, int hi) {
    p0 = f32x16{}; p1 = f32x16{};
#pragma unroll
    for (int d0 = 0; d0 < 6; ++d0) { const int cb = (d0 * 16 + hi * 8) * 2;
        bf16x8 b0 = *reinterpret_cast<const bf16x8*>(Ks + KSWZ(r32, cb));
        bf16x8 b1 = *reinterpret_cast<const bf16x8*>(Ks + KSWZ(32 + r32, cb));
        p0 = __builtin_amdgcn_mfma_f32_32x32x16_bf16(b0, qr[d0], p0, 0, 0, 0);
        p1 = __builtin_amdgcn_mfma_f32_32x32x16_bf16(b1, qr[d0], p1, 0, 0, 0); }
}
__device__ __forceinline__ int v_st(int k, int c) { const int kk = (k & ~0xC) | ((k & 4) << 1) | ((k & 8) >> 1); return ((kk >> 3) * 4 + (c >> 5)) * 512 + ((kk & 7) * 32 + (c & 31)) * 2; }
__device__ __forceinline__ int v_rd_base(int lane) { return ((lane & 3) << 3) | (((lane >> 2) & 3) << 6) | (((lane >> 4) & 1) << 5) | (((lane >> 5) & 1) << 8); }
constexpr int v_rd_off(int d0, int ks, int half) { return d0 * 512 + ks * 4096 + half * 2048; }
template <int OFF> __device__ __forceinline__ s16x4 tr_read(int vb) {
    s16x4 r; asm volatile("ds_read_b64_tr_b16 %0, %1 offset:%2" : "=&v"(r) : "v"(vb), "i"(OFF) : "memory"); return r;
}
template <int D0> __device__ __forceinline__ void pv_one(f32x16& od, int vb, bf16x8 pa0, bf16x8 pa1, bf16x8 pa2, bf16x8 pa3) {
    const s16x4 l0 = tr_read<v_rd_off(D0, 0, 0)>(vb), h0 = tr_read<v_rd_off(D0, 0, 1)>(vb), l1 = tr_read<v_rd_off(D0, 1, 0)>(vb), h1 = tr_read<v_rd_off(D0, 1, 1)>(vb);
    const s16x4 l2 = tr_read<v_rd_off(D0, 2, 0)>(vb), h2 = tr_read<v_rd_off(D0, 2, 1)>(vb), l3 = tr_read<v_rd_off(D0, 3, 0)>(vb), h3 = tr_read<v_rd_off(D0, 3, 1)>(vb);
    asm volatile("s_waitcnt lgkmcnt(0)" ::: "memory"); SBAR();
#define PK(L, H) (bf16x8){L[0], L[1], L[2], L[3], H[0], H[1], H[2], H[3]}
    od = __builtin_amdgcn_mfma_f32_32x32x16_bf16(pa0, PK(l0, h0), od, 0, 0, 0);
    od = __builtin_amdgcn_mfma_f32_32x32x16_bf16(pa1, PK(l1, h1), od, 0, 0, 0);
    od = __builtin_amdgcn_mfma_f32_32x32x16_bf16(pa2, PK(l2, h2), od, 0, 0, 0);
    od = __builtin_amdgcn_mfma_f32_32x32x16_bf16(pa3, PK(l3, h3), od, 0, 0, 0);
#undef PK
}
__device__ __forceinline__ void pv_d0(f32x16* o, int vb, bf16x8 pa0, bf16x8 pa1, bf16x8 pa2, bf16x8 pa3) {
    pv_one<0>(o[0], vb, pa0, pa1, pa2, pa3); pv_one<1>(o[1], vb, pa0, pa1, pa2, pa3);
}
__device__ __forceinline__ void attn_body(const bf16_t* __restrict__ Qb, const bf16_t* __restrict__ KVh, const bf16_t* __restrict__ KR, const float* __restrict__ ropeq,
                                          bf16_t* __restrict__ Ob, int seq, char* lds, const int tid) {
    const int wid = tid >> 6, lane = tid & 63, r32 = lane & 31, hi = lane >> 5;
    char* V_lds = lds; char* K_lds = lds + 3 * SHM_V;
    float* wsm = (float*)(lds + 3 * SHM_V + 3 * SHM_K) + wid * 64; float* li_l = wsm; float* al_l = wsm + 32;
    float m_reg = -1e30f, l_reg = 0; f32x16 o[2] = {}; bf16x8 qr[6];
    { const bf16_t* Qw = Qb + (size_t)(wid * QBLK + r32) * NQ + hi * 8;
#pragma unroll
      for (int d0 = 0; d0 < 4; ++d0) qr[d0] = *reinterpret_cast<const bf16x8*>(Qw + d0 * 16);
      const u32x4 w1 = *reinterpret_cast<const u32x4*>(Qw + 64), w2 = *reinterpret_cast<const u32x4*>(Qw + 80);
      float x1[8], x2[8]; unpack8(w1, x1); unpack8(w2, x2);
      const float* rp = ropeq + (size_t)(wid * QBLK + r32) * 32 + hi * 8;
      float y1[8], y2[8];
#pragma unroll
      for (int e = 0; e < 8; ++e) { const float c = rp[e], s = rp[16 + e]; y1[e] = x1[e] * c - x2[e] * s; y2[e] = x1[e] * s + x2[e] * c; }
      u32x4 o1 = {pk2(y1[0], y1[1]), pk2(y1[2], y1[3]), pk2(y1[4], y1[5]), pk2(y1[6], y1[7])};
      u32x4 o2 = {pk2(y2[0], y2[1]), pk2(y2[2], y2[3]), pk2(y2[4], y2[5]), pk2(y2[6], y2[7])};
      qr[4] = *reinterpret_cast<bf16x8*>(&o1); qr[5] = *reinterpret_cast<bf16x8*>(&o2); }
    const int sr = tid >> 4, c16 = tid & 15;
    const bool isK = c16 < 8;
    const int kst0 = KSWZ(sr, c16 * 16), kst1 = KSWZ(32 + sr, c16 * 16), vst0 = v_st(sr, (c16 & 7) * 8), vst1 = v_st(32 + sr, (c16 & 7) * 8);
    const int rkey = (tid & 255) >> 2, rch = tid & 3; const int rst = KSWZ(rkey, 128 + rch * 16); const bool rwr = tid < 256;
    const int vb0 = (int)(uintptr_t)V_lds + v_rd_base(lane);
    struct { bf16x8 a0, a1, rr; } sr_[2];
#define SLOAD(i, k0) do { sr_[i].a0 = *reinterpret_cast<const bf16x8*>(&KVh[(size_t)((k0) + sr) * NKV + c16 * 8]); sr_[i].a1 = *reinterpret_cast<const bf16x8*>(&KVh[(size_t)((k0) + 32 + sr) * NKV + c16 * 8]); \
    sr_[i].rr = *reinterpret_cast<const bf16x8*>(&KR[(size_t)((k0) + rkey) * 32 + rch * 8]); } while (0)
#define SWRITE(b, i) do { if (isK) { *(bf16x8*)(K_lds + (b) * SHM_K + kst0) = sr_[i].a0; *(bf16x8*)(K_lds + (b) * SHM_K + kst1) = sr_[i].a1; } \
    else { *(bf16x8*)(V_lds + (b) * SHM_V + vst0) = sr_[i].a0; *(bf16x8*)(V_lds + (b) * SHM_V + vst1) = sr_[i].a1; } \
    if (rwr) *(bf16x8*)(K_lds + (b) * SHM_K + rst) = sr_[i].rr; } while (0)
#define SWAIT() asm volatile("s_waitcnt vmcnt(3)" ::: "memory")
#define RESC(a) do { if (__any((a) < 1.f)) { if (hi == 0) al_l[r32] = (a); asm volatile("s_waitcnt lgkmcnt(0)" ::: "memory"); \
    _Pragma("unroll") for (int d = 0; d < 2; ++d) _Pragma("unroll") for (int r = 0; r < 16; ++r) o[d][r] *= al_l[crow(r, hi)]; } } while (0)
    f32x16 pA0, pA1, pB0, pB1; float mnA, mnB, alA, alB; bf16x8 pa0, pa1, pa2, pa3; const int NT = seq / KVBLK;
    constexpr int SE = 0, SO = 1;
    SLOAD(SE, 0); asm volatile("s_waitcnt vmcnt(0)" ::: "memory"); SWRITE(0, SE); __syncthreads();
    qkt(pA0, pA1, K_lds, qr, r32, hi); partialSM(pA0, pA1, m_reg, mnA, alA);
    SLOAD(SO, KVBLK); if (2 < NT) SLOAD(SE, 2 * KVBLK);
    SWAIT(); SWRITE(1, SO); __syncthreads();
    int bp = 0, bc = 1, bn = 2;
    for (int j = 1; j + 1 < NT; j += 2) {
        SBAR(); qkt(pB0, pB1, K_lds + bc * SHM_K, qr, r32, hi);
        finishSM(pA0, pA1, alA, l_reg, pa0, pa1, pa2, pa3); SBAR();
        SLOAD(SO, (j + 2) * KVBLK); SBAR();
        pv_d0(o, vb0 + bp * (int)SHM_V, pa0, pa1, pa2, pa3); partialSM(pB0, pB1, m_reg, mnB, alB);
        SWAIT(); SWRITE(bn, SE);
        RESC(alB); __syncthreads();
        { const int t = bp; bp = bc; bc = bn; bn = t; }
        SBAR(); qkt(pA0, pA1, K_lds + bc * SHM_K, qr, r32, hi);
        finishSM(pB0, pB1, alB, l_reg, pa0, pa1, pa2, pa3); SBAR();
        if (j + 3 < NT) SLOAD(SE, (j + 3) * KVBLK); SBAR();
        pv_d0(o, vb0 + bp * (int)SHM_V, pa0, pa1, pa2, pa3); partialSM(pA0, pA1, m_reg, mnA, alA);
        SWAIT(); SWRITE(bn, SO);
        RESC(alA); __syncthreads();
        { const int t = bp; bp = bc; bc = bn; bn = t; }
    }
    SBAR(); qkt(pB0, pB1, K_lds + bc * SHM_K, qr, r32, hi);
    finishSM(pA0, pA1, alA, l_reg, pa0, pa1, pa2, pa3); SBAR();
    pv_d0(o, vb0 + bp * (int)SHM_V, pa0, pa1, pa2, pa3); partialSM(pB0, pB1, m_reg, mnB, alB);
    RESC(alB);
    finishSM(pB0, pB1, alB, l_reg, pa0, pa1, pa2, pa3); SBAR();
    pv_d0(o, vb0 + bc * (int)SHM_V, pa0, pa1, pa2, pa3);
    if (hi == 0) li_l[r32] = l_reg; asm volatile("s_waitcnt lgkmcnt(0)" ::: "memory");
    float rli[16];
#pragma unroll
    for (int r = 0; r < 16; ++r) rli[r] = __builtin_amdgcn_rcpf(li_l[crow(r, hi)]);
    bf16_t* Ow = Ob + (size_t)(wid * QBLK) * DM;
#pragma unroll
    for (int r = 0; r < 16; ++r) { const int orow = crow(r, hi);
#pragma unroll
        for (int d0 = 0; d0 < 2; ++d0) Ow[(size_t)orow * DM + d0 * 32 + r32] = (bf16_t)f2bf(o[d0][r] * rli[r]); }
#undef SLOAD
#undef SWRITE
#undef SWAIT
#undef RESC
}
}

__device__ __forceinline__ void phase_attn(const Ctx& C, PP p, char* lds_generic) {
    unsigned char* ws = p->ws;
    const bf16_t* Q = (const bf16_t*)(ws + WS_BIG); const bf16_t* KV = (const bf16_t*)(ws + WS_KV); const bf16_t* KR = (const bf16_t*)(ws + WS_KR);
    const float* rope = (const float*)(ws + WS_ROPE); bf16_t* O = (bf16_t*)(ws + WS_HAB);
    for (int it = C.vcu; it < 2048; it += C.G) {
        const int qb = it & 15, h = (it >> 4) & 15, b = it >> 8; const size_t t0 = (size_t)b * SEQ, q0 = t0 + qb * 256;
        __syncthreads();
        att::attn_body(Q + q0 * NQ + h * 96, KV + t0 * NKV + h * 128, KR + t0 * 32, rope + q0 * 32, O + q0 * DM + h * 64, SEQ, lds_generic, C.tid);
    }
}


#define XB_TMO      128
#define XB_XCNT(j)  (256  + 64 * (j))
#define XB_XSUB(j)  (1280 + 64 * (j))
#define XB_XGEN(j)  (2304 + 64 * (j))
#define XB_TOP      3328
#define XB_TOPGEN   3392
#define XCD_BAR_WORDS 3456
#define XB_SPIN_CAP (1u << 22)
__device__ __forceinline__ unsigned xb_ld(unsigned* p)              { return __hip_atomic_load(p, __ATOMIC_RELAXED, __HIP_MEMORY_SCOPE_AGENT); }
__device__ __forceinline__ unsigned xb_add(unsigned* p, unsigned v) { return __hip_atomic_fetch_add(p, v, __ATOMIC_RELAXED, __HIP_MEMORY_SCOPE_AGENT); }
__device__ __forceinline__ unsigned xb_xcc_id() { return (unsigned)__builtin_amdgcn_s_getreg((3 << 11) | 20) & 0xFu; }
#define XB_SPIN(cond, bar) do { unsigned _sp = 0; while (cond) { __builtin_amdgcn_s_sleep(1); \
    if ((++_sp & 255u) == 0u) { if (xb_ld(&(bar)[XB_TMO])) break; if (_sp > XB_SPIN_CAP) { atomicAdd(&(bar)[XB_TMO], 1u); break; } } } } while (0)
__device__ __forceinline__ void xcd_barrier_complete(unsigned* bar, unsigned x, unsigned& nloc, unsigned& nx) {
    const unsigned G = gridDim.x * gridDim.y * gridDim.z;
    unsigned sum, cnt, mine, sp = 0u;
    for (;;) {
        sum = 0u; cnt = 0u; mine = 0u;
#pragma unroll
        for (unsigned j = 0; j < 16; ++j) { const unsigned c = xb_ld(&bar[XB_XCNT(j)]); sum += c; cnt += (c > 0u) ? 1u : 0u; mine = (j == x) ? c : mine; }
        if (sum == G) break;
        __builtin_amdgcn_s_sleep(1);
        if ((++sp & 255u) == 0u) { if (xb_ld(&bar[XB_TMO])) break; if (sp > XB_SPIN_CAP) { atomicAdd(&bar[XB_TMO], 1u); break; } }
    }
    nloc = mine > 0u ? mine : 1u; nx = cnt > 0u ? cnt : 1u;
}
__device__ __forceinline__ void xcd_barrier(unsigned* bar, volatile LAS unsigned* st) {
    asm volatile("s_waitcnt vmcnt(0)" ::: "memory");
    __syncthreads();
    if (threadIdx.x == 0) {
        const unsigned x = xb_xcc_id();
        __builtin_amdgcn_s_waitcnt(0);
        unsigned nloc = st[0], nx = st[1];
        if (nloc == 0u) { xcd_barrier_complete(bar, x, nloc, nx); st[0] = nloc; st[1] = nx; }
        const unsigned old = xb_add(&bar[XB_XSUB(x)], 1u);
        const unsigned gen = old / nloc;
        if (old + 1u == (gen + 1u) * nloc) {
            __builtin_amdgcn_fence(__ATOMIC_RELEASE, "agent");
            asm volatile("s_waitcnt vmcnt(0)" ::: "memory");
            const unsigned og = xb_add(&bar[XB_TOP], 1u);
            const unsigned tg = og / nx;
            if (og + 1u == (tg + 1u) * nx) xb_add(&bar[XB_TOPGEN], 1u);
            else XB_SPIN(xb_ld(&bar[XB_TOPGEN]) == tg, bar);
            __builtin_amdgcn_fence(__ATOMIC_ACQUIRE, "agent");
            xb_add(&bar[XB_XGEN(x)], 1u);
            asm volatile("s_waitcnt vmcnt(0)" ::: "memory");
        } else {
            XB_SPIN(xb_ld(&bar[XB_XGEN(x)]) == gen, bar);
            __builtin_amdgcn_fence(__ATOMIC_ACQUIRE, "agent");
            asm volatile("s_waitcnt vmcnt(0)" ::: "memory");
        }
    }
    __syncthreads();
}

constexpr int NPHASE = 42;
enum Kind { K_NOP = 0, K_PREP, K_NORM, K_GEMM_BF, K_GEMM_RES, K_M1, K_M2, K_M3, K_C2B, K_ATTN, K_FINAL };
__host__ __device__ inline int phase_kind(int ph) {
    if (ph == 0) return K_PREP; if (ph == NPHASE - 1) return K_FINAL;
    const int L = (ph - 1) / 10, s = (ph - 1) % 10;
    if ((L & 1) == 0) { const int k[10] = {K_NOP, K_GEMM_BF, K_M1, K_M2, K_M3, K_GEMM_RES, K_NOP, K_NOP, K_GEMM_BF, K_GEMM_RES}; return k[s]; }
    const int k[10] = {K_NOP, K_GEMM_BF, K_C2B, K_GEMM_BF, K_GEMM_BF, K_ATTN, K_GEMM_RES, K_NOP, K_GEMM_BF, K_GEMM_RES}; return k[s];
}
__host__ __device__ inline bool phase_sync_after(int ph) {
    if (ph == NPHASE - 1) return false;
    if (phase_kind(ph) == K_NOP) return false;
    const int L = (ph - 1) / 10, s = (ph - 1) % 10;
    if (ph > 0 && (L & 1) == 1 && s == 3) return false;
    return true;
}

__global__ void __launch_bounds__(NTHR, 2) mega(Params p_) {
    extern __shared__ __attribute__((aligned(16))) unsigned char lds_raw[];
    const int ph_hi = p_.ph_hi;
    volatile LAS unsigned* bst = (volatile LAS unsigned*)((LAS unsigned char*)lds_raw + LDS_BYTES - 16);
    if (threadIdx.x == 0) { bst[0] = 0u; bst[1] = 0u; if (ph_hi - p_.ph_lo > 1) (void)xb_add(&((unsigned*)p_.ws)[XB_XCNT(xb_xcc_id())], 1u); }
    __syncthreads();
    if (ph_hi > 100000) cg::this_grid().sync();
#define GRID_BAR() xcd_barrier((unsigned*)p->ws, bst)
#pragma unroll 1
    for (int ph = p_.ph_lo; ph < ph_hi; ++ph) {
        PP p = (PP)__builtin_amdgcn_kernarg_segment_ptr(); asm volatile("" : "+s"(p));
        unsigned char* ws = p->ws;
        float* xres = p->out;
        bf16_t* XN = (bf16_t*)(ws + WS_XN); bf16_t* HAB = (bf16_t*)(ws + WS_HAB); bf16_t* BIG = (bf16_t*)(ws + WS_BIG);
        const int kind = phase_kind(ph);
#pragma unroll 1
        for (int rep = 0; rep < (((DUP_MASK >> kind) & 1) ? 2 : 1); ++rep) {
        if (rep) GRID_BAR();
        int tid_ = threadIdx.x; asm volatile("" : "+v"(tid_));
        Ctx C; C.lds = (LAS unsigned char*)lds_raw; C.tid = tid_; C.lane = C.tid & 63; C.wave = __builtin_amdgcn_readfirstlane(C.tid >> 6);
        C.G = gridDim.x; { const int bx = blockIdx.x; C.vcu = (C.G % 8 == 0) ? (bx % 8) * (C.G / 8) + bx / 8 : bx; }
        const int L = (ph - 1) / 10, s = (ph - 1) % 10, j = L >> 1; const bool odd = (L & 1) != 0;
        switch (kind) {
        case K_PREP: phase_prep(C, p); break;
        case K_GEMM_BF: {
            pg8::Gemm g; pg8::EpiBf E;
            const float* SS = (const float*)(ws + WS_SS); const LAS float* RST = (const LAS float*)(C.lds + 131072);
            const bf16_t* XR = (const bf16_t*)xres;
            if (s == 8) { g = pg8::Gemm{XR, (const bf16_t*)(ws + W_F1) + (size_t)L * DFF * DM, TOK, DFF, DM}; E = pg8::EpiBf{BIG, DFF, 1, RST, nullptr, nullptr}; }
            else if (!odd) { g = pg8::Gemm{XR, (const bf16_t*)(ws + W_ABIN) + (size_t)j * PNG * DM, TOK, PN, DM}; E = pg8::EpiBf{BIG, PN, 2, RST, (float*)(ws + WS_GATES), p->in[I_ABGB] + (size_t)j * 16}; }
            else if (s == 1) { g = pg8::Gemm{XR, (const bf16_t*)(ws + W_CIN) + (size_t)j * CINP * DM, TOK, CINP, DM}; E = pg8::EpiBf{HAB, CINP, 0, RST, nullptr, nullptr}; }
            else if (s == 3) { g = pg8::Gemm{(const bf16_t*)(ws + WS_CQN), (const bf16_t*)(ws + W_CUQ) + (size_t)j * NQ * QL, TOK, NQ, QL}; E = pg8::EpiBf{BIG, NQ, 0, nullptr, nullptr, nullptr}; }
            else { g = pg8::Gemm{(const bf16_t*)(ws + WS_CKVN), (const bf16_t*)(ws + W_CUKV) + (size_t)j * NKV * KVL, TOK, NKV, KVL}; E = pg8::EpiBf{(bf16_t*)(ws + WS_KV), NKV, 0, nullptr, nullptr, nullptr}; }
            pg8::StaticOrder S; S.init(g.M, g.N, C.G, (int)blockIdx.x);
            if (E.rst) {
                LAS float* rw = (LAS float*)(C.lds + 131072); LAS int* upm = (LAS int*)(C.lds + 131072 + 8192);
                if (C.tid < 8) { pg8::Unit uu; upm[C.tid] = S.next(C.tid, uu) ? uu.pm : -1; }
                __syncthreads();
                const int par = C.wave >> 2, rrow = C.tid & 255;
                const int pm0 = upm[par], pm1 = upm[par + 2], pm2 = upm[par + 4], pm3 = upm[par + 6];
                f32x4 t0 = (f32x4){0.f, 0.f, 0.f, 0.f}, t1 = t0, t2 = t0, t3 = t0;
                if (pm0 >= 0) { const float* sp = SS + (size_t)(pm0 * 256 + rrow) * 16; t0 = (*(const f32x4*)(sp) + *(const f32x4*)(sp + 4)) + (*(const f32x4*)(sp + 8) + *(const f32x4*)(sp + 12)); }
                if (pm1 >= 0) { const float* sp = SS + (size_t)(pm1 * 256 + rrow) * 16; t1 = (*(const f32x4*)(sp) + *(const f32x4*)(sp + 4)) + (*(const f32x4*)(sp + 8) + *(const f32x4*)(sp + 12)); }
                if (pm2 >= 0) { const float* sp = SS + (size_t)(pm2 * 256 + rrow) * 16; t2 = (*(const f32x4*)(sp) + *(const f32x4*)(sp + 4)) + (*(const f32x4*)(sp + 8) + *(const f32x4*)(sp + 12)); }
                if (pm3 >= 0) { const float* sp = SS + (size_t)(pm3 * 256 + rrow) * 16; t3 = (*(const f32x4*)(sp) + *(const f32x4*)(sp + 4)) + (*(const f32x4*)(sp + 8) + *(const f32x4*)(sp + 12)); }
                if (pm0 >= 0) rw[(par + 0) * 256 + rrow] = 1.f / sqrtf(((t0.x + t0.y) + (t0.z + t0.w)) * (1.f / DM) + EPS);
                if (pm1 >= 0) rw[(par + 2) * 256 + rrow] = 1.f / sqrtf(((t1.x + t1.y) + (t1.z + t1.w)) * (1.f / DM) + EPS);
                if (pm2 >= 0) rw[(par + 4) * 256 + rrow] = 1.f / sqrtf(((t2.x + t2.y) + (t2.z + t2.w)) * (1.f / DM) + EPS);
                if (pm3 >= 0) rw[(par + 6) * 256 + rrow] = 1.f / sqrtf(((t3.x + t3.y) + (t3.z + t3.w)) * (1.f / DM) + EPS);
                __syncthreads(); }
            if (!odd && s == 1) {
                const bf16_t* WGt = (const bf16_t*)(ws + W_ABIN) + (size_t)j * PNG * DM + (size_t)PN * DM; const float* gb = p->in[I_ABGB] + (size_t)j * 16; float* gates = (float*)(ws + WS_GATES);
                const int fr = C.lane & 15, fq = C.lane >> 4;
                for (int rg = C.vcu * 8 + C.wave; rg < TOK / 16; rg += C.G * 8) { const int r0 = rg * 16;
                    f32x4 ga = (f32x4){0.f, 0.f, 0.f, 0.f};
                    const bf16_t* ap = XR + (size_t)(r0 + fr) * DM + fq * 8; const bf16_t* bp = WGt + (size_t)fr * DM + fq * 8;
#pragma unroll 16
                    for (int kk = 0; kk < 32; ++kk) { const bf16x8 av = *(const bf16x8*)(ap + kk * 32), bv = *(const bf16x8*)(bp + kk * 32); ga = __builtin_amdgcn_mfma_f32_16x16x32_bf16(av, bv, ga, 0, 0, 0); }
                    const float* sp = SS + (size_t)(r0 + fr) * 16;
                    const f32x4 t = (*(const f32x4*)(sp) + *(const f32x4*)(sp + 4)) + (*(const f32x4*)(sp + 8) + *(const f32x4*)(sp + 12));
                    const float rsl = 1.f / sqrtf(((t.x + t.y) + (t.z + t.w)) * (1.f / DM) + EPS);
                    const float bq = gb[fr];
#pragma unroll
                    for (int jj = 0; jj < 4; ++jj) { const int mrow = fq * 4 + jj; float x = ga[jj] * __shfl(rsl, mrow) + bq;
                        if ((fr >> 2) & 1) x = fminf(x, 0.f) - log1pf(__expf(-fabsf(x)));
                        gates[(size_t)(r0 + mrow) * 16 + fr] = x; } } }
            pg8::gemm_phase<pg8::EpiBf>(C.lds, g, S, E, C.tid);
        } break;
        case K_GEMM_RES: {
            pg8::Gemm g; pg8::EpiRes E;
            float* SS = (float*)(ws + WS_SS);
            bf16_t* XR = (bf16_t*)xres;
            if (s == 9) { g = pg8::Gemm{BIG, (const bf16_t*)(ws + W_F2) + (size_t)L * DM * DFF, TOK, DM, DFF}; E = pg8::EpiRes{XR, (L == 3) ? XN : XR, SS}; }
            else if (!odd) { g = pg8::Gemm{HAB, (const bf16_t*)(ws + W_ABOUT) + (size_t)j * DM * DM, TOK, DM, DM}; E = pg8::EpiRes{XR, XR, SS}; }
            else { g = pg8::Gemm{HAB, (const bf16_t*)(ws + W_COUT) + (size_t)j * DM * DM, TOK, DM, DM}; E = pg8::EpiRes{XR, XR, SS}; }
            pg8::StaticOrder S; S.init(g.M, g.N, C.G, (int)blockIdx.x);
            pg8::gemm_phase<pg8::EpiRes>(C.lds, g, S, E, C.tid);
        } break;
        case K_M1: phase_m1_sgu(C, p, j); break;
        case K_M2: phase_m2(C, p); break;
        case K_M3: phase_m3(C, p, j); break;
        case K_C2B: phase_c2b(C, HAB, p->in[I_CQG] + (size_t)j * QL, p->in[I_CKVG] + (size_t)j * KVL, (const float*)(ws + WS_ROPE), (bf16_t*)(ws + WS_CQN), (bf16_t*)(ws + WS_CKVN), (bf16_t*)(ws + WS_KR)); break;
        case K_ATTN: phase_attn(C, p, (char*)lds_raw); __syncthreads(); break;
        case K_FINAL: phase_final_norm(C, XN, xres, p->in[I_FINAL]); break;
        default: break;
        }
        }
        if (ph + 1 < ph_hi && phase_sync_after(ph)) { GRID_BAR(); }
        else __syncthreads();
    }
}

extern "C" void kernel_launch(void* const* d_in, const int* in_sizes, int n_in, void* d_out, int out_size, void* d_ws, size_t ws_size, hipStream_t stream) {
    static int grid = 0;
    if (grid == 0) {
        if (n_in != 22 || out_size != TOK * DM || ws_size < WS_END) { fprintf(stderr, "kernel_launch: unexpected shapes n_in %d out %d ws %zu (need %zu)\n", n_in, out_size, ws_size, (size_t)WS_END); grid = -1; return; }
        int dev = 0, cus = 0, per_cu = 0;
        hipGetDevice(&dev); hipDeviceGetAttribute(&cus, hipDeviceAttributeMultiprocessorCount, dev);
        if (hipFuncSetAttribute((const void*)mega, hipFuncAttributeMaxDynamicSharedMemorySize, LDS_BYTES) != hipSuccess) { fprintf(stderr, "kernel_launch: hipFuncSetAttribute failed\n"); grid = -1; return; }
        if (hipOccupancyMaxActiveBlocksPerMultiprocessor(&per_cu, (const void*)mega, NTHR, LDS_BYTES) != hipSuccess || per_cu < 1) { fprintf(stderr, "kernel_launch: occupancy query says %d\n", per_cu); per_cu = 1; }
        (void)hipGetLastError();
        grid = cus * 1;
        if (grid <= 0) grid = 256;
    }
    if (grid < 0) return;
    if (hipMemsetAsync(d_ws, 0, 16384, stream) != hipSuccess) { fprintf(stderr, "kernel_launch: memset failed\n"); return; }
    Params hp{};
    for (int i = 0; i < 22; ++i) hp.in[i] = (const float*)d_in[i];
    hp.out = (float*)d_out; hp.ws = (unsigned char*)d_ws;
#if MK_MULTI
    for (int ph = 0; ph < NPHASE; ++ph) {
        if (phase_kind(ph) == K_NOP) continue;
        hp.ph_lo = ph; hp.ph_hi = ph + 1;
        hipLaunchKernelGGL(mega, dim3(grid), dim3(NTHR), LDS_BYTES, stream, hp);
    }
#else
    hp.ph_lo = 0; hp.ph_hi = NPHASE;
    void* args[] = {&hp};
    hipError_t e = hipLaunchCooperativeKernel((const void*)mega, dim3(grid), dim3(NTHR), args, LDS_BYTES, stream);
    if (e != hipSuccess) fprintf(stderr, "cooperative launch failed: %s (grid %d)\n", hipGetErrorString(e), grid);
#endif
}
```

```cpp
#include <hip/hip_runtime.h>
#include <hip/hip_cooperative_groups.h>
#include <cstdio>
namespace cg = cooperative_groups;

#ifndef DUP_MASK
#define DUP_MASK 0
#endif
#ifndef MK_MULTI
#define MK_MULTI 0
#endif

#define LAS __attribute__((address_space(3)))
typedef unsigned short bf16_t;
typedef short bf16x8 __attribute__((ext_vector_type(8)));
typedef short s16x4 __attribute__((ext_vector_type(4)));
typedef float f32x4 __attribute__((ext_vector_type(4)));
typedef float f32x16 __attribute__((ext_vector_type(16)));
typedef unsigned u32x4 __attribute__((ext_vector_type(4)));
typedef unsigned u32x2 __attribute__((ext_vector_type(2)));

constexpr int NB = 8, SEQ = 4096, DM = 1024, TOK = NB * SEQ;
constexpr int ABN = 3088;
constexpr int PNG = 3104;
constexpr int PN = 3072;
constexpr int CIN = 672, CINP = 768;
constexpr int QL = 384, KVL = 256;
constexpr int NQ = 1536, NKV = 2048;
constexpr int DFF = 4096;
constexpr float EPS = 1e-6f;

constexpr size_t MiB = 1u << 20;
constexpr size_t WS_ROPE = 1 * MiB;
constexpr size_t WS_GATES = 5 * MiB;
constexpr size_t WS_STAT = 7 * MiB;
constexpr size_t WS_MPREV = 7 * MiB + 65536;
constexpr size_t WS_NLOC = 8 * MiB;
constexpr size_t WS_SS = 10 * MiB;
constexpr size_t WS_W = 12 * MiB;
constexpr size_t W_ABIN = WS_W;
constexpr size_t W_ABOUT = W_ABIN + 2ull * PNG * DM * 2;
constexpr size_t W_CIN = W_ABOUT + 2ull * DM * DM * 2;
constexpr size_t W_CUQ = W_CIN + 2ull * CINP * DM * 2;
constexpr size_t W_CUKV = W_CUQ + 2ull * NQ * QL * 2;
constexpr size_t W_COUT = W_CUKV + 2ull * NKV * KVL * 2;
constexpr size_t W_F1 = W_COUT + 2ull * DM * DM * 2;
constexpr size_t W_F2 = W_F1 + 4ull * DFF * DM * 2;
constexpr size_t W_END = W_F2 + 4ull * DFF * DM * 2;
static_assert(W_END <= 108 * MiB, "weights fit");
constexpr size_t WS_HAB = 108 * MiB;
constexpr size_t WS_BIG = 172 * MiB;
constexpr size_t WS_XN = 428 * MiB;
constexpr size_t WS_CLOC = WS_BIG + 192 * MiB;
constexpr size_t WS_END = 492 * MiB;
constexpr size_t WS_KV = WS_BIG + 96 * MiB;
constexpr size_t WS_CQN = WS_XN, WS_CKVN = WS_XN + 24 * MiB, WS_KR = WS_XN + 40 * MiB;

constexpr int LDS_BYTES = 155648;
constexpr int NTHR = 512;

__device__ __forceinline__ unsigned f2bf(float f) { unsigned u = __builtin_bit_cast(unsigned, f); return (u + 0x7fffu + ((u >> 16) & 1u)) >> 16; }
__device__ __forceinline__ unsigned pk2(float lo, float hi) { return f2bf(lo) | (f2bf(hi) << 16); }
__device__ __forceinline__ float bflo(unsigned w) { return __builtin_bit_cast(float, w << 16); }
__device__ __forceinline__ float bfhi(unsigned w) { return __builtin_bit_cast(float, w & 0xffff0000u); }
__device__ __forceinline__ float bf2f(bf16_t b) { return __builtin_bit_cast(float, ((unsigned)b) << 16); }
__device__ __forceinline__ unsigned cvtpk(float lo, float hi) { unsigned r; asm volatile("v_cvt_pk_bf16_f32 %0, %1, %2" : "=v"(r) : "v"(lo), "v"(hi)); return r; }
__device__ __forceinline__ float wave_sum(float v) {
#pragma unroll
    for (int o = 1; o < 64; o <<= 1) v += __shfl_xor(v, o);
    return v;
}
__device__ __forceinline__ float rows4_sum(float x) {
    { auto r = __builtin_amdgcn_permlane16_swap(__float_as_uint(x), __float_as_uint(x), false, false); x = __uint_as_float(r[0]) + __uint_as_float(r[1]); }
    { auto r = __builtin_amdgcn_permlane32_swap(__float_as_uint(x), __float_as_uint(x), false, false); x = __uint_as_float(r[0]) + __uint_as_float(r[1]); }
    return x;
}
__device__ __forceinline__ void unpack8(u32x4 w, float* x) {
    x[0] = bflo(w.x); x[1] = bfhi(w.x); x[2] = bflo(w.y); x[3] = bfhi(w.y); x[4] = bflo(w.z); x[5] = bfhi(w.z); x[6] = bflo(w.w); x[7] = bfhi(w.w);
}
#define LDS_WAIT() asm volatile("s_waitcnt lgkmcnt(0)" ::: "memory")

namespace pg8 {
constexpr int BM = 256, BK = 64, HALF = 128, HTB = HALF * BK * 2, STAGE_BYTES = 8 * HTB, NXCD = 8, WGM = 8;
__device__ __forceinline__ int lds_byte(int r, int c) { const int st = (r >> 4) * 2 + (c >> 5), rr = r & 15, cc = c & 31, ob = rr * 64 + cc * 2; return st * 1024 + (ob ^ (((ob >> 9) & 1) << 5)); }
__device__ __forceinline__ void stage_rc(int b, int& R, int& C) { const int st = b / 1024, sb = b % 1024, swz = sb ^ (((sb >> 9) & 1) << 5); R = (st >> 1) * 16 + swz / 64; C = (st & 1) * 32 + (swz % 64) / 2; }
__device__ __forceinline__ int perm32(int rho) { const int n = rho >> 4, i = rho & 15; return 8 * (i >> 2) + 4 * n + (i & 3); }
struct Unit { int pm, pn, idx; };
struct Gemm { const bf16_t* A; const bf16_t* Bt; int M, N, K; };
struct StaticOrder {
    int nM, nN, nwg, G, c;
    __device__ void init(int M, int N, int G_, int c_) { nM = M / BM; nN = N / BM; nwg = nM * nN; G = G_; c = c_; }
    __device__ bool next(int i, Unit& u) const {
        const long L = (long)i * G + c; if (L >= nwg) return false;
        int wgid = (int)L; { const int q = nwg / NXCD, r = nwg % NXCD, xcd = wgid % NXCD, off = wgid / NXCD; wgid = (xcd < r ? xcd * (q + 1) : r * (q + 1) + (xcd - r) * q) + off; }
        const int nig = WGM * nN, gid = wgid / nig, fm = gid * WGM, gsz = (nM - fm) < WGM ? (nM - fm) : WGM;
        u.pm = fm + ((wgid % nig) % gsz); u.pn = (wgid % nig) / gsz; u.idx = i; return true;
    }
};
struct EpiRes {
    static constexpr bool PERM = false;
    const bf16_t* base; bf16_t* out; float* ss;
    __device__ __forceinline__ void operator()(const f32x4 (&acc)[2][2][4][2], const Unit& u, int wr, int wc, int fr, int fq) const {
        const int row0 = u.pm * BM + wr * 64 + fr, col0 = u.pn * BM + wc * 32 + 4 * fq;
#pragma unroll
        for (int ai = 0; ai < 2; ++ai) {
            u32x2 b[4][2][2];
#pragma unroll
            for (int m = 0; m < 4; ++m)
#pragma unroll
                for (int bj = 0; bj < 2; ++bj)
#pragma unroll
                    for (int n = 0; n < 2; ++n) b[m][bj][n] = *(const u32x2*)(base + (size_t)(row0 + ai * HALF + m * 16) * DM + col0 + bj * HALF + n * 16);
            asm volatile("" ::: "memory");
#pragma unroll
            for (int m = 0; m < 4; ++m) { const int row = row0 + ai * HALF + m * 16; const size_t off = (size_t)row * DM + col0; float sq = 0.f;
#pragma unroll
                for (int bj = 0; bj < 2; ++bj)
#pragma unroll
                    for (int n = 0; n < 2; ++n) { const size_t o = off + bj * HALF + n * 16; const u32x2 bw = b[m][bj][n];
                        const f32x4 v = (f32x4){bflo(bw.x), bfhi(bw.x), bflo(bw.y), bfhi(bw.y)} + acc[ai][bj][m][n];
                        u32x2 w; w.x = cvtpk(v.x, v.y); w.y = cvtpk(v.z, v.w); *(u32x2*)(out + o) = w;
                        const float r0 = bflo(w.x), r1 = bfhi(w.x), r2 = bflo(w.y), r3 = bfhi(w.y);
                        sq += (r0 * r0 + r1 * r1) + (r2 * r2 + r3 * r3); }
                sq = rows4_sum(sq);
                if (fq == 0) ss[(size_t)row * 16 + u.pn * 4 + wc] = sq; }
            asm volatile("" ::: "memory"); }
    }
};
struct EpiBf {
    static constexpr bool PERM = true;
    bf16_t* O; int ldc; int act; const LAS float* rst; float* gates; const float* gate_b;
    __device__ __forceinline__ void operator()(const f32x4 (&acc)[2][2][4][2], const Unit& u, int wr, int wc, int fr, int fq) const {
        const int row0 = u.pm * BM + wr * 64 + fr, col0 = u.pn * BM + wc * 32 + 8 * fq;
        const int a = (act == 2) ? ((u.pn >= 8) ? 2 : 0) : act;
        const bool gate_tile = (act == 2) && (u.pn == 12);
        if (gate_tile && !(wc == 0 && fq < 2)) return;
#pragma unroll
        for (int ai = 0; ai < 2; ++ai)
#pragma unroll
            for (int m = 0; m < 4; ++m) { const int row = row0 + ai * HALF + m * 16;
                const float rs = rst ? rst[u.idx * 256 + (row - u.pm * BM)] : 1.f;
                if (gate_tile) {
#pragma unroll
                    for (int n = 0; n < 2; ++n) { const int q0 = 8 * fq + 4 * n; f32x4 x = acc[ai][0][m][n] * rs + *(const f32x4*)(gate_b + q0);
                        if ((q0 >> 2) & 1) {
#pragma unroll
                            for (int j = 0; j < 4; ++j) x[j] = fminf(x[j], 0.f) - log1pf(__expf(-fabsf(x[j]))); }
                        *(f32x4*)(gates + (size_t)row * 16 + q0) = x; }
                    continue; }
                bf16_t* rowp = O + (size_t)row * ldc + col0;
#pragma unroll
                for (int bj = 0; bj < 2; ++bj) { float v[8];
#pragma unroll
                    for (int j = 0; j < 4; ++j) { v[j] = acc[ai][bj][m][0][j] * rs; v[4 + j] = acc[ai][bj][m][1][j] * rs; }
                    if (a == 1) {
#pragma unroll
                        for (int j = 0; j < 8; ++j) { const float r = fmaxf(v[j], 0.f); v[j] = r * r; }
                    } else if (a == 2) {
#pragma unroll
                        for (int j = 0; j < 8; ++j) { const float x = v[j]; const float z = 0.7978845608028654f * (x + 0.044715f * x * x * x);
                            const float e = __builtin_amdgcn_exp2f(z * 2.885390081777927f); v[j] = x * (1.f - __builtin_amdgcn_rcpf(1.f + e)); }
                    }
                    u32x4 w; w.x = cvtpk(v[0], v[1]); w.y = cvtpk(v[2], v[3]); w.z = cvtpk(v[4], v[5]); w.w = cvtpk(v[6], v[7]);
                    *(u32x4*)(rowp + bj * HALF) = w; } }
    }
};

template <class Epi>
__device__ __forceinline__ void gemm_phase(LAS unsigned char* lds, const Gemm g, const StaticOrder& S, const Epi& E, const int tid) {
    const int wid = __builtin_amdgcn_readfirstlane(tid >> 6), lane = tid & 63, wr = wid >> 2, wc = wid & 3, fr = lane & 15, fq = lane >> 4;
    const int K = g.K, nt = K / BK;
    unsigned voffA[2], voffB[2];
#pragma unroll
    for (int i = 0; i < 2; ++i) { int R, C; stage_rc(tid * 16 + i * 8192, R, C); const int Rb = Epi::PERM ? ((R & ~31) + perm32(R & 31)) : R;
        voffA[i] = (unsigned)(R * K + C) * 2u; voffB[i] = (unsigned)(Rb * K + C) * 2u; }
    const size_t kstep = (size_t)(BK * 2);
    const size_t hstep = (size_t)HALF * K * 2;
    const size_t tstep = 2 * hstep;
    const unsigned ldsw = (unsigned)wid * 1024u;
    const int aoff = lds_byte(wr * 64 + fr, fq * 8), boff = lds_byte(wc * 32 + fr, fq * 8);
#define PG8_SA(b, h) (((b) * 2 + (h)) * HTB)
#define PG8_SB(b, h) ((4 + (b) * 2 + (h)) * HTB)
#define PG8_STAGE(bufoff, gbase, voff) do { _Pragma("unroll") for (int _i = 0; _i < 2; ++_i) \
        __builtin_amdgcn_global_load_lds((const unsigned*)((const char*)(gbase) + (voff)[_i]), (LAS unsigned*)(lds + (bufoff) + ldsw + _i * 8192), 16, 0, 0); } while (0)
#define PG8_LDA(dst, b, h) do { _Pragma("unroll") for (int m = 0; m < 4; ++m) _Pragma("unroll") for (int k = 0; k < 2; ++k) dst[m][k] = *(const LAS bf16x8*)(lds + PG8_SA(b, h) + aoff + m * 2048 + k * 1024); } while (0)
#define PG8_LDB(dst, b, h) do { _Pragma("unroll") for (int n = 0; n < 2; ++n) _Pragma("unroll") for (int k = 0; k < 2; ++k) dst[n][k] = *(const LAS bf16x8*)(lds + PG8_SB(b, h) + boff + n * 2048 + k * 1024); } while (0)
#define PG8_MMA(ai, bj, At, Bt) do { __builtin_amdgcn_s_setprio(1); _Pragma("unroll") for (int m = 0; m < 4; ++m) _Pragma("unroll") for (int n = 0; n < 2; ++n) _Pragma("unroll") for (int k = 0; k < 2; ++k) \
        acc[ai][bj][m][n] = __builtin_amdgcn_mfma_f32_16x16x32_bf16(Bt[n][k], At[m][k], acc[ai][bj][m][n], 0, 0, 0); __builtin_amdgcn_s_setprio(0); } while (0)
#define PG8_WAIT_V(n) asm volatile("s_waitcnt vmcnt(" #n ")" ::: "memory")
#define PG8_WAIT_L(n) asm volatile("s_waitcnt lgkmcnt(" #n ")" ::: "memory")
#define PG8_BAR __builtin_amdgcn_s_barrier()
#define PG8_SCHED __builtin_amdgcn_sched_barrier(0)
    Unit cur, nxt; int ui = 0;
    if (!S.next(0, cur)) return;
    f32x4 acc[2][2][4][2];
#pragma unroll
    for (int a = 0; a < 2; ++a)
#pragma unroll
        for (int b = 0; b < 2; ++b)
#pragma unroll
            for (int m = 0; m < 4; ++m)
#pragma unroll
                for (int n = 0; n < 2; ++n) acc[a][b][m][n] = (f32x4){0.f, 0.f, 0.f, 0.f};
    bf16x8 At[4][2], B0[2][2], B1[2][2];
    const char* cA = (const char*)g.A + (size_t)cur.pm * tstep; const char* cB = (const char*)g.Bt + (size_t)cur.pn * tstep;
    PG8_STAGE(PG8_SB(0, 0), cB, voffB); PG8_STAGE(PG8_SB(0, 1), cB + hstep, voffB); PG8_STAGE(PG8_SA(0, 0), cA, voffA); PG8_STAGE(PG8_SA(0, 1), cA + hstep, voffA);
    if (wr == 1) PG8_BAR;
    PG8_WAIT_V(2); PG8_BAR;
    PG8_STAGE(PG8_SB(1, 0), cB + kstep, voffB); PG8_STAGE(PG8_SA(1, 0), cA + kstep, voffA); PG8_STAGE(PG8_SB(1, 1), cB + hstep + kstep, voffB);
    PG8_WAIT_V(6); PG8_BAR;
    for (;;) {
        const bool has_next = S.next(ui + 1, nxt);
        const char* nA = has_next ? (const char*)g.A + (size_t)nxt.pm * tstep : cA; const char* nB = has_next ? (const char*)g.Bt + (size_t)nxt.pn * tstep : cB;
        for (int t = 0; t < nt; t += 2) {
            const bool last = (t == nt - 2);
            const char* a1 = cA + (size_t)(t + 1) * kstep;
            const char* a2 = last ? nA : cA + (size_t)(t + 2) * kstep; const char* b2 = last ? nB : cB + (size_t)(t + 2) * kstep;
            const char* a3 = a2 + kstep; const char* b3 = b2 + kstep;
            PG8_LDB(B0, 0, 0); PG8_LDB(B1, 0, 1); PG8_SCHED; PG8_LDA(At, 0, 0); PG8_STAGE(PG8_SA(1, 1), a1 + hstep, voffA);
            PG8_WAIT_V(8); PG8_WAIT_L(0); PG8_BAR; PG8_MMA(0, 0, At, B0); PG8_MMA(0, 1, At, B1); PG8_BAR; PG8_SCHED;
            PG8_LDA(At, 0, 1); PG8_STAGE(PG8_SB(0, 0), b2, voffB); PG8_STAGE(PG8_SB(0, 1), b2 + hstep, voffB); PG8_STAGE(PG8_SA(0, 0), a2, voffA);
            PG8_WAIT_V(8); PG8_WAIT_L(0); PG8_BAR; PG8_MMA(1, 0, At, B0); PG8_MMA(1, 1, At, B1); PG8_BAR; PG8_SCHED;
            PG8_LDB(B0, 1, 0); PG8_LDB(B1, 1, 1); PG8_SCHED; PG8_LDA(At, 1, 0); PG8_STAGE(PG8_SA(0, 1), a2 + hstep, voffA);
            PG8_WAIT_V(8); PG8_WAIT_L(0); PG8_BAR; PG8_MMA(0, 0, At, B0); PG8_MMA(0, 1, At, B1); PG8_BAR; PG8_SCHED;
            PG8_LDA(At, 1, 1); PG8_STAGE(PG8_SB(1, 0), b3, voffB); PG8_STAGE(PG8_SB(1, 1), b3 + hstep, voffB); PG8_STAGE(PG8_SA(1, 0), a3, voffA);
            PG8_WAIT_V(8); PG8_WAIT_L(0); PG8_BAR; PG8_MMA(1, 0, At, B0); PG8_MMA(1, 1, At, B1); PG8_BAR; PG8_SCHED;
        }
        if (wr == 0) PG8_BAR;
        E(acc, cur, wr, wc, fr, fq);
        if (!has_next) break;
#pragma unroll
        for (int a = 0; a < 2; ++a)
#pragma unroll
            for (int b = 0; b < 2; ++b)
#pragma unroll
                for (int m = 0; m < 4; ++m)
#pragma unroll
                    for (int n = 0; n < 2; ++n) acc[a][b][m][n] = (f32x4){0.f, 0.f, 0.f, 0.f};
        cur = nxt; cA = nA; cB = nB; ++ui;
        if (wr == 1) PG8_BAR;
    }
    PG8_WAIT_V(0);
    PG8_BAR;
#undef PG8_SA
#undef PG8_SB
#undef PG8_STAGE
#undef PG8_LDA
#undef PG8_LDB
#undef PG8_MMA
#undef PG8_WAIT_V
#undef PG8_WAIT_L
#undef PG8_BAR
#undef PG8_SCHED
}
}

struct Params {
    const float* in[22];
    float* out; unsigned char* ws;
    int ph_lo, ph_hi;
};
enum { I_X = 0, I_POS, I_ABNORM, I_ABWIN, I_ABCONV, I_ABGB, I_ABHG, I_ABVG, I_ABWS, I_ABBS, I_ABWOUT, I_CNORM, I_CWIN, I_CQG, I_CKVG, I_CWUQ, I_CWUKV, I_CWOUT,
       I_FNORM, I_FW1, I_FW2, I_FINAL };

typedef const __attribute__((address_space(4))) Params* PP;
struct Ctx { LAS unsigned char* lds; int tid, lane, wave, vcu, G; };

__device__ __forceinline__ void transpose_weight(const Ctx& C, const float* W, int K, int ld, int c0, int ncols, bf16_t* WT, int r0, const float* gk = nullptr) {
    LAS float* scr = (LAS float*)(C.lds + C.wave * 16384);
    const int gw = C.vcu * 8 + C.wave, NGW = C.G * 8, lane = C.lane;
    const int nblk = ncols / 32, nitems = (K / 64) * nblk;
    for (int item = gw; item < nitems; item += NGW) {
        const int kb = item / nblk, nb = item % nblk, k0 = 64 * kb, n0 = 32 * nb;
#pragma unroll
        for (int i = 0; i < 32; ++i) { const int kk = 2 * i + (lane >> 5); scr[kk * 33 + (lane & 31)] = W[(size_t)(k0 + kk) * ld + c0 + n0 + (lane & 31)] * (gk ? gk[k0 + kk] : 1.f); }
        LDS_WAIT(); asm volatile("" ::: "memory");
        const int c = lane & 7;
#pragma unroll
        for (int j = 0; j < 4; ++j) { const int n = (lane >> 3) + 8 * j; const LAS float* s = scr + (8 * c) * 33 + n;
            u32x4 o; o.x = pk2(s[0 * 33], s[1 * 33]); o.y = pk2(s[2 * 33], s[3 * 33]); o.z = pk2(s[4 * 33], s[5 * 33]); o.w = pk2(s[6 * 33], s[7 * 33]);
            *(u32x4*)(WT + (size_t)(r0 + n0 + n) * K + k0 + 8 * c) = o; }
        LDS_WAIT(); asm volatile("" ::: "memory");
    }
}
struct TDesc { const float* W; bf16_t* WT; const float* gk; int K, ld; };
constexpr int TI_FFN = 4 * 4096, TI_J = 1024 + 512 + 16 + 512 + 336 + 288 + 256 + 512, TI_ALL = TI_FFN + 2 * TI_J;
__device__ __forceinline__ TDesc tdecode(PP p, unsigned char* ws, int it) {
    TDesc d; const float* W; bf16_t* WT; const float* gk = nullptr; int K, ld, c0 = 0, r0 = 0, nblk, r;
    if (it < TI_FFN) { const int l = it >> 12; r = it & 4095;
        if (r < 2048) { W = p->in[I_FW1] + (size_t)l * DM * DFF; K = DM; ld = DFF; nblk = 128; WT = (bf16_t*)(ws + W_F1) + (size_t)l * DFF * DM; gk = p->in[I_FNORM] + (size_t)l * DM; }
        else { r -= 2048; W = p->in[I_FW2] + (size_t)l * DFF * DM; K = DFF; ld = DM; nblk = 32; WT = (bf16_t*)(ws + W_F2) + (size_t)l * DM * DFF; }
    } else { const int i2 = it - TI_FFN, j = i2 / TI_J; r = i2 % TI_J;
        if (r < 1552) { W = p->in[I_ABWIN] + (size_t)j * DM * ABN; K = DM; ld = ABN; WT = (bf16_t*)(ws + W_ABIN) + (size_t)j * PNG * DM; gk = p->in[I_ABNORM] + (size_t)j * DM;
            if (r < 1024) { nblk = 64; } else if (r < 1536) { r -= 1024; nblk = 32; c0 = 2064; r0 = 2048; } else { r -= 1536; nblk = 1; c0 = 2048; r0 = 3072; } }
        else if (r < 2064) { r -= 1552; W = p->in[I_ABWOUT] + (size_t)j * DM * DM; K = DM; ld = DM; nblk = 32; WT = (bf16_t*)(ws + W_ABOUT) + (size_t)j * DM * DM; }
        else if (r < 2400) { r -= 2064; W = p->in[I_CWIN] + (size_t)j * DM * CIN; K = DM; ld = CIN; nblk = 21; WT = (bf16_t*)(ws + W_CIN) + (size_t)j * CINP * DM; gk = p->in[I_CNORM] + (size_t)j * DM; }
        else if (r < 2688) { r -= 2400; W = p->in[I_CWUQ] + (size_t)j * QL * NQ; K = QL; ld = NQ; nblk = 48; WT = (bf16_t*)(ws + W_CUQ) + (size_t)j * NQ * QL; }
        else if (r < 2944) { r -= 2688; W = p->in[I_CWUKV] + (size_t)j * KVL * NKV; K = KVL; ld = NKV; nblk = 64; WT = (bf16_t*)(ws + W_CUKV) + (size_t)j * NKV * KVL; }
        else { r -= 2944; W = p->in[I_CWOUT] + (size_t)j * DM * DM; K = DM; ld = DM; nblk = 32; WT = (bf16_t*)(ws + W_COUT) + (size_t)j * DM * DM; }
    }
    const int kb = r / nblk, nb = r % nblk, k0 = 64 * kb, n0 = 32 * nb;
    d.W = W + (size_t)k0 * ld + c0 + n0; d.WT = WT + (size_t)(r0 + n0) * K + k0; d.gk = gk ? gk + k0 : nullptr; d.K = K; d.ld = ld;
    return d;
}
__device__ __forceinline__ void tload(const TDesc& d, int lane, float (&v)[32], f32x4 (&g)[2]) {
#pragma unroll
    for (int i = 0; i < 32; ++i) v[i] = __builtin_nontemporal_load(d.W + (size_t)(2 * i + (lane >> 5)) * d.ld + (lane & 31));
    if (d.gk) { g[0] = *(const f32x4*)(d.gk + 8 * (lane & 7)); g[1] = *(const f32x4*)(d.gk + 8 * (lane & 7) + 4); }
    else { g[0] = (f32x4){1.f, 1.f, 1.f, 1.f}; g[1] = g[0]; }
}
__device__ __forceinline__ void phase_prep(const Ctx& C, PP p) {
    unsigned char* ws = p->ws;
    { LAS float* scr = (LAS float*)(C.lds + C.wave * 16384);
      const int gw = C.vcu * 8 + C.wave, NGW = C.G * 8, lane = C.lane, c = lane & 7;
      int it = gw; TDesc d; float v[32]; f32x4 g[2];
      if (it < TI_ALL) { d = tdecode(p, ws, it); tload(d, lane, v, g); }
      while (it < TI_ALL) {
          const int itn = it + NGW; TDesc dn = d; float vn[32]; f32x4 gn[2];
          if (itn < TI_ALL) { dn = tdecode(p, ws, itn); tload(dn, lane, vn, gn); }
          else {
#pragma unroll
              for (int i = 0; i < 32; ++i) vn[i] = 0.f;
              gn[0] = g[0]; gn[1] = g[1]; }
#pragma unroll
          for (int i = 0; i < 32; ++i) scr[(2 * i + (lane >> 5)) * 33 + (lane & 31)] = v[i];
          LDS_WAIT(); asm volatile("" ::: "memory");
#pragma unroll
          for (int j = 0; j < 4; ++j) { const int n = (lane >> 3) + 8 * j; const LAS float* sp = scr + (8 * c) * 33 + n;
              u32x4 o; o.x = pk2(sp[0 * 33] * g[0].x, sp[1 * 33] * g[0].y); o.y = pk2(sp[2 * 33] * g[0].z, sp[3 * 33] * g[0].w);
              o.z = pk2(sp[4 * 33] * g[1].x, sp[5 * 33] * g[1].y); o.w = pk2(sp[6 * 33] * g[1].z, sp[7 * 33] * g[1].w);
              *(u32x4*)(d.WT + (size_t)n * d.K + 8 * c) = o; }
          LDS_WAIT(); asm volatile("" ::: "memory");
          d = dn; g[0] = gn[0]; g[1] = gn[1];
#pragma unroll
          for (int i = 0; i < 32; ++i) v[i] = vn[i];
          it = itn; } }
    const int gt = C.vcu * NTHR + C.tid, NGT = C.G * NTHR;
    for (int i = gt; i < 2 * 12288; i += NGT) { const int j = i / 12288, r = i % 12288;
        unsigned zz; asm volatile("v_mov_b32 %0, 0" : "=v"(zz));
        *(u32x4*)((bf16_t*)(ws + W_CIN) + (size_t)j * CINP * DM + (size_t)CIN * DM + (size_t)r * 8) = (u32x4){zz, zz, zz, zz}; }
    { const int gw = C.vcu * 8 + C.wave, NGW = C.G * 8, lane = C.lane; const float* x = p->in[I_X]; bf16_t* xb = (bf16_t*)p->out; float* ss0 = (float*)(ws + WS_SS);
      for (int r = gw; r < TOK; r += 2 * NGW) { const int r2 = (r + NGW < TOK) ? r + NGW : r;
          const f32x4* xr = (const f32x4*)(x + (size_t)r * DM) + lane; const f32x4* xr2 = (const f32x4*)(x + (size_t)r2 * DM) + lane; f32x4 v[4], u[4]; float sq = 0.f, sq2 = 0.f;
#pragma unroll
          for (int jj = 0; jj < 4; ++jj) { v[jj] = __builtin_nontemporal_load(xr + 64 * jj); u[jj] = __builtin_nontemporal_load(xr2 + 64 * jj); }
#pragma unroll
          for (int jj = 0; jj < 4; ++jj) { sq += (v[jj].x * v[jj].x + v[jj].y * v[jj].y) + (v[jj].z * v[jj].z + v[jj].w * v[jj].w); sq2 += (u[jj].x * u[jj].x + u[jj].y * u[jj].y) + (u[jj].z * u[jj].z + u[jj].w * u[jj].w); }
          unsigned long long* o8 = (unsigned long long*)(xb + (size_t)r * DM) + lane; unsigned long long* o82 = (unsigned long long*)(xb + (size_t)r2 * DM) + lane;
#pragma unroll
          for (int jj = 0; jj < 4; ++jj) { o8[64 * jj] = (unsigned long long)pk2(v[jj].x, v[jj].y) | ((unsigned long long)pk2(v[jj].z, v[jj].w) << 32);
              o82[64 * jj] = (unsigned long long)pk2(u[jj].x, u[jj].y) | ((unsigned long long)pk2(u[jj].z, u[jj].w) << 32); }
          sq = wave_sum(sq); sq2 = wave_sum(sq2);
          if (lane < 16) { ss0[(size_t)r * 16 + lane] = (lane == 0) ? sq : 0.f; ss0[(size_t)r2 * 16 + lane] = (lane == 0) ? sq2 : 0.f; } } }
    const int* pos = (const int*)p->in[I_POS]; float* rope = (float*)(ws + WS_ROPE);
    for (int i = gt; i < TOK * 16; i += NGT) { const int t = i >> 4, j = i & 15;
        const float freq = __builtin_amdgcn_exp2f(-(float)j * 0.8304820237218406f);
        const float ang = (float)pos[t] * freq;
        const float kq = rintf(ang * 0.15915494309189535f);
        float rr = fmaf(-kq, 6.28125f, ang); rr = fmaf(-kq, 0.0019353071795864769f, rr);
        const float fr = rr * 0.15915494309189535f;
        rope[(size_t)t * 32 + j] = __builtin_amdgcn_cosf(fr); rope[(size_t)t * 32 + 16 + j] = __builtin_amdgcn_sinf(fr); }
}

__device__ __forceinline__ void phase_norm(const Ctx& C, const float* src, const float* g, bf16_t* dst, const float* wg_src  , const float* gate_b, float* gates) {
    LAS float* wgt = (LAS float*)C.lds;
    if (wg_src) {
        for (int i = C.tid; i < 1024 * 4; i += NTHR) { const int c = i >> 2, q = i & 3; const f32x4 v = *(const f32x4*)(wg_src + (size_t)c * ABN + 2048 + q * 4);
            wgt[(q * 4 + 0) * 1024 + c] = v.x; wgt[(q * 4 + 1) * 1024 + c] = v.y; wgt[(q * 4 + 2) * 1024 + c] = v.z; wgt[(q * 4 + 3) * 1024 + c] = v.w; }
        __syncthreads();
    }
    const int gw = C.vcu * 8 + C.wave, NGW = C.G * 8, lane = C.lane;
    f32x4 gv[4];
#pragma unroll
    for (int j = 0; j < 4; ++j) gv[j] = *(const f32x4*)(g + 4 * lane + 256 * j);
    for (int r = gw; r < TOK; r += NGW) {
        const f32x4* xr = (const f32x4*)(src + (size_t)r * DM) + lane;
        f32x4 v[4]; float s = 0.f;
#pragma unroll
        for (int j = 0; j < 4; ++j) { v[j] = xr[64 * j]; s += (v[j].x * v[j].x + v[j].y * v[j].y) + (v[j].z * v[j].z + v[j].w * v[j].w); }
        const float rs = 1.f / sqrtf(wave_sum(s) * (1.f / DM) + EPS);
        unsigned long long* o8 = (unsigned long long*)(dst + (size_t)r * DM) + lane;
#pragma unroll
        for (int j = 0; j < 4; ++j) { v[j] = v[j] * rs * gv[j]; o8[64 * j] = (unsigned long long)pk2(v[j].x, v[j].y) | ((unsigned long long)pk2(v[j].z, v[j].w) << 32); }
        if (wg_src) {
            float acc[16];
#pragma unroll
            for (int q = 0; q < 16; ++q) { float a = 0.f;
#pragma unroll
                for (int j = 0; j < 4; ++j) { const f32x4 w = *(const LAS f32x4*)(wgt + q * 1024 + 4 * lane + 256 * j); a += (v[j].x * w.x + v[j].y * w.y) + (v[j].z * w.z + v[j].w * w.w); }
                acc[q] = a; }
            float a8[8], a4[4], a2[2], a1;
            { const bool up = (lane & 32) != 0;
#pragma unroll
              for (int i = 0; i < 8; ++i) { const float send = up ? acc[i] : acc[i + 8], keep = up ? acc[i + 8] : acc[i]; a8[i] = keep + __shfl_xor(send, 32); } }
            { const bool up = (lane & 16) != 0;
#pragma unroll
              for (int i = 0; i < 4; ++i) { const float send = up ? a8[i] : a8[i + 4], keep = up ? a8[i + 4] : a8[i]; a4[i] = keep + __shfl_xor(send, 16); } }
            { const bool up = (lane & 8) != 0;
#pragma unroll
              for (int i = 0; i < 2; ++i) { const float send = up ? a4[i] : a4[i + 2], keep = up ? a4[i + 2] : a4[i]; a2[i] = keep + __shfl_xor(send, 8); } }
            { const bool up = (lane & 4) != 0; const float send = up ? a2[0] : a2[1], keep = up ? a2[1] : a2[0]; a1 = keep + __shfl_xor(send, 4); }
            a1 += __shfl_xor(a1, 1); a1 += __shfl_xor(a1, 2);
            if ((lane & 3) == 0) { const int q = lane >> 2; float x = a1 + gate_b[q];
                if ((q >> 2) & 1) x = fminf(x, 0.f) - log1pf(__expf(-fabsf(x)));
                gates[(size_t)r * 16 + q] = x; }
        }
    }
}
__device__ __forceinline__ void phase_final_norm(const Ctx& C, const bf16_t* xb, float* out, const float* g) {
    const int gw = C.vcu * 8 + C.wave, NGW = C.G * 8, lane = C.lane;
    f32x4 gv[4];
#pragma unroll
    for (int j = 0; j < 4; ++j) gv[j] = *(const f32x4*)(g + 4 * lane + 256 * j);
    constexpr int RB = 4;
    for (int r0 = gw; r0 < TOK; r0 += RB * NGW) {
        u32x2 w[RB][4]; int rr[RB];
#pragma unroll
        for (int u = 0; u < RB; ++u) { const int r = (r0 + u * NGW < TOK) ? r0 + u * NGW : r0; rr[u] = r; const u32x2* xr = (const u32x2*)(xb + (size_t)r * DM) + lane;
#pragma unroll
            for (int j = 0; j < 4; ++j) w[u][j] = __builtin_nontemporal_load(xr + 64 * j); }
#pragma unroll
        for (int u = 0; u < RB; ++u) { f32x4 v[4]; float s = 0.f;
#pragma unroll
            for (int j = 0; j < 4; ++j) { v[j] = (f32x4){bflo(w[u][j].x), bfhi(w[u][j].x), bflo(w[u][j].y), bfhi(w[u][j].y)}; s += (v[j].x * v[j].x + v[j].y * v[j].y) + (v[j].z * v[j].z + v[j].w * v[j].w); }
            const float rs = 1.f / sqrtf(wave_sum(s) * (1.f / DM) + EPS);
            f32x4* o = (f32x4*)(out + (size_t)rr[u] * DM) + lane;
#pragma unroll
            for (int j = 0; j < 4; ++j) o[64 * j] = v[j] * rs * gv[j]; }
    }
}
__device__ __forceinline__ void phase_c2b(const Ctx& C, const bf16_t* cqkv, const float* qg, const float* kvg, const float* rope, bf16_t* cqn, bf16_t* ckvn, bf16_t* kr) {
    const int gw = C.vcu * 8 + C.wave, NGW = C.G * 8, lane = C.lane;
    float gq[6], gk[4];
#pragma unroll
    for (int i = 0; i < 6; ++i) gq[i] = qg[lane * 6 + i];
#pragma unroll
    for (int i = 0; i < 4; ++i) gk[i] = kvg[lane * 4 + i];
    constexpr int RB = 4;
    for (int r0 = gw; r0 < TOK; r0 += RB * NGW) {
        unsigned w0[RB], w1[RB], w2[RB]; u32x2 kw[RB]; bf16_t x1b[RB], x2b[RB]; float cs[RB], sn[RB]; int rr[RB];
#pragma unroll
        for (int u = 0; u < RB; ++u) { const int r = (r0 + u * NGW < TOK) ? r0 + u * NGW : r0; rr[u] = r;
            const bf16_t* row = cqkv + (size_t)r * CINP; const unsigned* q32 = (const unsigned*)(row + lane * 6);
            w0[u] = __builtin_nontemporal_load(q32); w1[u] = __builtin_nontemporal_load(q32 + 1); w2[u] = __builtin_nontemporal_load(q32 + 2); kw[u] = __builtin_nontemporal_load((const u32x2*)(row + QL + lane * 4));
            x1b[u] = row[QL + KVL + (lane & 15)]; x2b[u] = row[QL + KVL + 16 + (lane & 15)];
            cs[u] = rope[(size_t)r * 32 + (lane & 15)]; sn[u] = rope[(size_t)r * 32 + 16 + (lane & 15)]; }
#pragma unroll
        for (int u = 0; u < RB; ++u) { const int r = rr[u];
            float q[6] = {bflo(w0[u]), bfhi(w0[u]), bflo(w1[u]), bfhi(w1[u]), bflo(w2[u]), bfhi(w2[u])};
            float k[4] = {bflo(kw[u].x), bfhi(kw[u].x), bflo(kw[u].y), bfhi(kw[u].y)};
            float sq = 0.f, sk = 0.f;
#pragma unroll
            for (int i = 0; i < 6; ++i) sq += q[i] * q[i];
#pragma unroll
            for (int i = 0; i < 4; ++i) sk += k[i] * k[i];
            const float rq = 1.f / sqrtf(wave_sum(sq) * (1.f / QL) + EPS), rk = 1.f / sqrtf(wave_sum(sk) * (1.f / KVL) + EPS);
            unsigned* oq = (unsigned*)(cqn + (size_t)r * QL + lane * 6);
            oq[0] = pk2(q[0] * rq * gq[0], q[1] * rq * gq[1]); oq[1] = pk2(q[2] * rq * gq[2], q[3] * rq * gq[3]); oq[2] = pk2(q[4] * rq * gq[4], q[5] * rq * gq[5]);
            u32x2 ok; ok.x = pk2(k[0] * rk * gk[0], k[1] * rk * gk[1]); ok.y = pk2(k[2] * rk * gk[2], k[3] * rk * gk[3]);
            *(u32x2*)(ckvn + (size_t)r * KVL + lane * 4) = ok;
            if (lane < 16) { const float x1 = bf2f(x1b[u]), x2 = bf2f(x2b[u]);
                kr[(size_t)r * 32 + lane] = (bf16_t)f2bf(x1 * cs[u] - x2 * sn[u]); kr[(size_t)r * 32 + 16 + lane] = (bf16_t)f2bf(x1 * sn[u] + x2 * cs[u]); } }
    }
}

constexpr int TP = 136;
constexpr int TILE_B = 128 * TP * 2;
__device__ __forceinline__ void mm128T(f32x4 (&acc)[2][4], const LAS bf16_t* A, const LAS bf16_t* B, int wr, int wc, int fr, int fq) {
#pragma unroll
    for (int kk = 0; kk < 4; ++kk) {
        bf16x8 a[2], b[4];
#pragma unroll
        for (int mt = 0; mt < 2; ++mt) a[mt] = *(const LAS bf16x8*)(A + (wr * 32 + mt * 16 + fr) * TP + kk * 32 + fq * 8);
#pragma unroll
        for (int nt = 0; nt < 4; ++nt) b[nt] = *(const LAS bf16x8*)(B + (wc * 64 + nt * 16 + fr) * TP + kk * 32 + fq * 8);
#pragma unroll
        for (int mt = 0; mt < 2; ++mt)
#pragma unroll
            for (int nt = 0; nt < 4; ++nt) acc[mt][nt] = __builtin_amdgcn_mfma_f32_16x16x32_bf16(b[nt], a[mt], acc[mt][nt], 0, 0, 0);
    }
}
__device__ __forceinline__ void zero_acc(f32x4 (&acc)[2][4]) {
#pragma unroll
    for (int mt = 0; mt < 2; ++mt)
#pragma unroll
        for (int nt = 0; nt < 4; ++nt) acc[mt][nt] = (f32x4){0.f, 0.f, 0.f, 0.f};
}
template <bool NT> __device__ __forceinline__ void conv_load(const bf16_t* P, size_t tokbase, int l0, int col, int rg, u32x4 (&raw)[8]) {
#pragma unroll
    for (int r = 0; r < 8; ++r) { const int lp = l0 + rg * 4 - 2 + r;
        if (lp >= 0 && lp < SEQ) raw[r] = NT ? __builtin_nontemporal_load((const u32x4*)(P + (tokbase + lp) * PN + col)) : *(const u32x4*)(P + (tokbase + lp) * PN + col);
        else raw[r] = (u32x4){0u, 0u, 0u, 0u}; }
}
__device__ __forceinline__ void conv_compute(const u32x4 (&raw)[8], const float* cw, int col, float scale, float (&out)[4][8]) {
    float w[5][8];
#pragma unroll
    for (int j = 0; j < 5; ++j) { const f32x4 a = *(const f32x4*)(cw + j * 1024 + col), b = *(const f32x4*)(cw + j * 1024 + col + 4);
        w[j][0] = a.x; w[j][1] = a.y; w[j][2] = a.z; w[j][3] = a.w; w[j][4] = b.x; w[j][5] = b.y; w[j][6] = b.z; w[j][7] = b.w; }
#pragma unroll
    for (int i = 0; i < 4; ++i)
#pragma unroll
        for (int e = 0; e < 8; ++e) out[i][e] = 0.f;
#pragma unroll
    for (int r = 0; r < 8; ++r) { float x[8]; unpack8(raw[r], x);
#pragma unroll
        for (int i = 0; i < 4; ++i) { const int j = r - i; if (j >= 0 && j < 5) {
#pragma unroll
            for (int e = 0; e < 8; ++e) out[i][e] += w[j][e] * x[e]; } }
    }
#pragma unroll
    for (int i = 0; i < 4; ++i)
#pragma unroll
        for (int e = 0; e < 8; ++e) { const float v = out[i][e]; out[i][e] = v * __builtin_amdgcn_rcpf(1.f + __expf(-v)) * scale; }
}
__device__ __forceinline__ void gate_scan(const float* G  , int h, int d, int lane, LAS float* a_out, LAS float* b_out, LAS float* cm_out, float& gtot, float& amax) {
    const int i0 = 2 * lane, t0 = d ? 127 - i0 : i0, t1 = d ? 126 - i0 : i0 + 1;
    const float li0 = G[t0 * 16 + d * 8 + h], lf0 = G[t0 * 16 + d * 8 + 4 + h], li1 = G[t1 * 16 + d * 8 + h], lf1 = G[t1 * 16 + d * 8 + 4 + h];
    const float s = lf0 + lf1; float incl = s;
#pragma unroll
    for (int off = 1; off < 64; off <<= 1) { const float v = __shfl_up(incl, off); if (lane >= off) incl += v; }
    const float excl = incl - s, b0 = excl + lf0, b1 = incl;
    const float a0 = li0 - b0, a1 = li1 - b1;
    float mx = fmaxf(a0, a1);
#pragma unroll
    for (int off = 1; off < 64; off <<= 1) { const float v = __shfl_up(mx, off); if (lane >= off) mx = fmaxf(mx, v); }
    float pm = __shfl_up(mx, 1); if (lane == 0) pm = -3.0e38f;
    a_out[t0] = a0; a_out[t1] = a1; b_out[t0] = b0; b_out[t1] = b1; cm_out[t0] = fmaxf(pm, a0); cm_out[t1] = mx;
    gtot = __shfl(incl, 63); amax = __shfl(mx, 63);
}

constexpr int SM_OFF = 4 * TILE_B;
__device__ __forceinline__ void phase_m1_sgu(const Ctx& C, PP p, int j) {
    unsigned char* ws = p->ws;
    const bf16_t* P = (const bf16_t*)(ws + WS_BIG);
    const float* gates = (const float*)(ws + WS_GATES);
    bf16_t* cloc = (bf16_t*)(ws + WS_CLOC); float* nloc = (float*)(ws + WS_NLOC); float* stat = (float*)(ws + WS_STAT);
    bf16_t* hab = (bf16_t*)(ws + WS_HAB);
    const float* cw = p->in[I_ABCONV] + (size_t)j * 5 * 1024;
    LAS bf16_t* VT = (LAS bf16_t*)(C.lds); LAS bf16_t* KF = (LAS bf16_t*)(C.lds + TILE_B); LAS bf16_t* KB = (LAS bf16_t*)(C.lds + 2 * TILE_B);
    LAS float* sm = (LAS float*)(C.lds + SM_OFF);
    const int tid = C.tid, lane = C.lane, wid = C.wave, wr = wid >> 1, wc = wid & 1, fr = lane & 15, fq = lane >> 4;
    const int cc = tid & 15, rg = tid >> 4;
    for (int it = C.vcu; it < 2048; it += C.G) {
        __syncthreads();
        if (it < 1024) {
            const int b = it >> 7, h = (it >> 5) & 3, pc = it & 31; const size_t tokbase = (size_t)b * SEQ; const int l0 = pc * 128;
            u32x4 kraw[8], vraw[4];
            conv_load<false>(P, tokbase, l0, 512 + h * 128 + cc * 8, rg, kraw);
#pragma unroll
            for (int i = 0; i < 4; ++i) vraw[i] = *(const u32x4*)(P + (tokbase + l0 + rg * 4 + i) * PN + 1024 + h * 128 + cc * 8);
            if (wid < 2) { float gt, am; gate_scan(gates + (tokbase + l0) * 16, h, wid, lane, sm + wid * 384, sm + wid * 384 + 128, sm + wid * 384 + 256, gt, am);
                const int i0 = 2 * lane, t0 = wid ? 127 - i0 : i0, t1 = wid ? 126 - i0 : i0 + 1;
                LDS_WAIT();
                sm[768 + wid * 128 + t0] = __expf(sm[wid * 384 + t0] - am); sm[768 + wid * 128 + t1] = __expf(sm[wid * 384 + t1] - am);
                if (lane == 0) { const int sidx = ((b * 4 + h) * 2 + wid) * 32 + pc; stat[sidx * 2] = gt; stat[sidx * 2 + 1] = am; } }
            __syncthreads();
            { float k[4][8]; conv_compute(kraw, cw, 512 + h * 128 + cc * 8, 1.f, k);
              float wf[4], wb[4];
#pragma unroll
              for (int i = 0; i < 4; ++i) { wf[i] = sm[768 + rg * 4 + i]; wb[i] = sm[896 + rg * 4 + i]; }
#pragma unroll
              for (int e = 0; e < 8; ++e) { u32x2 a, bb; a.x = pk2(k[0][e] * wf[0], k[1][e] * wf[1]); a.y = pk2(k[2][e] * wf[2], k[3][e] * wf[3]);
                  bb.x = pk2(k[0][e] * wb[0], k[1][e] * wb[1]); bb.y = pk2(k[2][e] * wb[2], k[3][e] * wb[3]);
                  *(LAS u32x2*)(KF + (cc * 8 + e) * TP + rg * 4) = a; *(LAS u32x2*)(KB + (cc * 8 + e) * TP + rg * 4) = bb; } }
            { float v[4][8];
#pragma unroll
              for (int i = 0; i < 4; ++i) unpack8(vraw[i], v[i]);
#pragma unroll
              for (int e = 0; e < 8; ++e) { u32x2 a; a.x = pk2(v[0][e], v[1][e]); a.y = pk2(v[2][e], v[3][e]); *(LAS u32x2*)(VT + (cc * 8 + e) * TP + rg * 4) = a; } }
            __syncthreads();
#pragma unroll 1
            for (int d = 0; d < 2; ++d) {
                f32x4 acc[2][4]; zero_acc(acc);
                mm128T(acc, VT, d ? KB : KF, wr, wc, fr, fq);
                bf16_t* ct = cloc + ((size_t)(((b * 4 + h) * 2 + d) * 32 + pc)) * 16384;
#pragma unroll
                for (int mt = 0; mt < 2; ++mt)
#pragma unroll
                    for (int nt = 0; nt < 4; ++nt) { u32x2 w; w.x = pk2(acc[mt][nt][0], acc[mt][nt][1]); w.y = pk2(acc[mt][nt][2], acc[mt][nt][3]);
                        *(u32x2*)(ct + (wr * 32 + mt * 16 + fr) * 128 + wc * 64 + nt * 16 + fq * 4) = w; }
            }
            if (tid < 256) { const int d = tid >> 7, dd = tid & 127; const LAS bf16_t* row = (d ? KB : KF) + dd * TP; float s = 0.f;
#pragma unroll
                for (int q = 0; q < 16; ++q) { const u32x4 w = *(const LAS u32x4*)(row + q * 8); float x[8]; unpack8(w, x);
#pragma unroll
                    for (int e = 0; e < 8; ++e) s += x[e]; }
                nloc[((size_t)(((b * 4 + h) * 2 + d) * 32 + pc)) * 128 + dd] = s; }
        } else {
            const int it2 = it - 1024, b = it2 >> 7, n = (it2 >> 2) & 31, gi = it2 & 3; const size_t row0 = (size_t)b * SEQ + n * 128;
            LAS bf16_t* AW = KF; LAS bf16_t* VBT = VT;
            const int r = tid >> 2, q = tid & 3;
            { const float* wsrc = p->in[I_ABWS] + ((size_t)(j * 4 + gi) * 128 + r) * 128 + q * 32;
#pragma unroll
              for (int c8 = 0; c8 < 4; ++c8) { const f32x4 a = *(const f32x4*)(wsrc + c8 * 8), bb = *(const f32x4*)(wsrc + c8 * 8 + 4);
                  u32x4 w; w.x = pk2(a.x, a.y); w.y = pk2(a.z, a.w); w.z = pk2(bb.x, bb.y); w.w = pk2(bb.z, bb.w);
                  *(LAS u32x4*)(AW + r * TP + q * 32 + c8 * 8) = w; } }
            { const bf16_t* vsrc = P + (row0 + r) * PN + 2560 + gi * 128 + q * 32; float x[32]; float ss = 0.f;
#pragma unroll
              for (int c8 = 0; c8 < 4; ++c8) { const u32x4 w = __builtin_nontemporal_load((const u32x4*)(vsrc + c8 * 8)); unpack8(w, x + c8 * 8); }
#pragma unroll
              for (int e = 0; e < 32; ++e) ss += x[e] * x[e];
              ss += __shfl_xor(ss, 1); ss += __shfl_xor(ss, 2);
              const float rs = 1.f / sqrtf(ss * (1.f / 128.f) + EPS);
              const float* vg = p->in[I_ABVG] + (size_t)j * 512 + gi * 128 + q * 32;
#pragma unroll
              for (int e = 0; e < 32; ++e) VBT[(q * 32 + e) * TP + r] = (bf16_t)f2bf(x[e] * rs * vg[e]); }
            u32x2 uraw[2][4];
#pragma unroll
            for (int mt = 0; mt < 2; ++mt)
#pragma unroll
                for (int nt = 0; nt < 4; ++nt) uraw[mt][nt] = __builtin_nontemporal_load((const u32x2*)(P + (row0 + wr * 32 + mt * 16 + fr) * PN + 2048 + gi * 128 + wc * 64 + nt * 16 + fq * 4));
            __syncthreads();
            f32x4 acc[2][4]; zero_acc(acc);
            mm128T(acc, AW, VBT, wr, wc, fr, fq);
            const float* bs = p->in[I_ABBS] + (size_t)(j * 4 + gi) * 128;
#pragma unroll
            for (int mt = 0; mt < 2; ++mt) { const int t = wr * 32 + mt * 16 + fr; const float bt = bs[t];
#pragma unroll
                for (int nt = 0; nt < 4; ++nt) { const int c = wc * 64 + nt * 16 + fq * 4;
                    const u32x2 uw = uraw[mt][nt];
                    u32x2 o; o.x = pk2(bflo(uw.x) * (acc[mt][nt][0] + bt), bfhi(uw.x) * (acc[mt][nt][1] + bt)); o.y = pk2(bflo(uw.y) * (acc[mt][nt][2] + bt), bfhi(uw.y) * (acc[mt][nt][3] + bt));
                    *(u32x2*)(hab + (row0 + t) * DM + 512 + gi * 128 + c) = o; } }
        }
    }
}
__device__ __forceinline__ void phase_m2(const Ctx& C, PP p) {
    unsigned char* ws = p->ws;
    bf16_t* cloc = (bf16_t*)(ws + WS_CLOC); float* nloc = (float*)(ws + WS_NLOC); const float* stat = (const float*)(ws + WS_STAT); float* mprev = (float*)(ws + WS_MPREV);
    const int gt = C.vcu * NTHR + C.tid, NGT = C.G * NTHR;
    for (int idx = gt; idx < 64 * 2048; idx += NGT) {
        const int seq = idx >> 11, slot = idx & 2047, d = seq & 1; const bool has_n = slot < 32;
        bf16_t* base = cloc + (size_t)seq * 32 * 16384 + slot * 8; float* nbase = nloc + (size_t)seq * 32 * 128 + (slot & 31) * 4;
        float st[8]; f32x4 nst = (f32x4){0.f, 0.f, 0.f, 0.f}; float m = 0.f;
#pragma unroll
        for (int e = 0; e < 8; ++e) st[e] = 0.f;
        u32x4 cur[8], nxt[8]; f32x4 ncur[8], nnxt[8];
#pragma unroll
        for (int u = 0; u < 8; ++u) { const int pc = d ? 31 - u : u; cur[u] = *(const u32x4*)(base + (size_t)pc * 16384); ncur[u] = has_n ? *(const f32x4*)(nbase + (size_t)pc * 128) : nst; }
#pragma unroll 1
        for (int c0 = 0; c0 < 32; c0 += 8) {
            if (c0 + 8 < 32) {
#pragma unroll
                for (int u = 0; u < 8; ++u) { const int pc = d ? 31 - (c0 + 8 + u) : c0 + 8 + u; nxt[u] = *(const u32x4*)(base + (size_t)pc * 16384); nnxt[u] = has_n ? *(const f32x4*)(nbase + (size_t)pc * 128) : nst; }
            }
#pragma unroll
            for (int u = 0; u < 8; ++u) { const int pc = d ? 31 - (c0 + u) : c0 + u;
                const float g = stat[(seq * 32 + pc) * 2], am = stat[(seq * 32 + pc) * 2 + 1];
                u32x4 w; w.x = pk2(st[0], st[1]); w.y = pk2(st[2], st[3]); w.z = pk2(st[4], st[5]); w.w = pk2(st[6], st[7]);
                *(u32x4*)(base + (size_t)pc * 16384) = w;
                if (has_n) *(f32x4*)(nbase + (size_t)pc * 128) = nst;
                if (slot == 0) mprev[seq * 32 + pc] = m;
                const float M = fmaxf(m, am), decay = __expf(m - M), sc = __expf(am - M);
                float x[8]; unpack8(cur[u], x);
#pragma unroll
                for (int e = 0; e < 8; ++e) st[e] = st[e] * decay + x[e] * sc;
                nst = nst * decay + ncur[u] * sc;
                m = g + M; }
#pragma unroll
            for (int u = 0; u < 8; ++u) { cur[u] = nxt[u]; ncur[u] = nnxt[u]; }
        }
    }
}
__device__ __forceinline__ void phase_m3(const Ctx& C, PP p, int j) {
    unsigned char* ws = p->ws;
    const bf16_t* P = (const bf16_t*)(ws + WS_BIG);
    const float* gates = (const float*)(ws + WS_GATES);
    const bf16_t* cprev = (const bf16_t*)(ws + WS_CLOC); const float* nprev = (const float*)(ws + WS_NLOC); const float* mprev = (const float*)(ws + WS_MPREV);
    bf16_t* hab = (bf16_t*)(ws + WS_HAB);
    const float* cw = p->in[I_ABCONV] + (size_t)j * 5 * 1024;
    const float* hg = p->in[I_ABHG] + (size_t)j * 512;
    LAS bf16_t* QS = (LAS bf16_t*)(C.lds); LAS bf16_t* KS = (LAS bf16_t*)(C.lds + TILE_B); LAS bf16_t* VT = (LAS bf16_t*)(C.lds + 2 * TILE_B); LAS bf16_t* CT = (LAS bf16_t*)(C.lds + 3 * TILE_B);
    LAS float* sm = (LAS float*)(C.lds + SM_OFF);
    const int tid = C.tid, lane = C.lane, wid = C.wave, wr = wid >> 1, wc = wid & 1, fr = lane & 15, fq = lane >> 4;
    const int cc = tid & 15, rg = tid >> 4;
    for (int it = C.vcu; it < 1024; it += C.G) {
        const int b = it >> 7, h = (it >> 5) & 3, pc = it & 31; const size_t tokbase = (size_t)b * SEQ; const int l0 = pc * 128;
        __syncthreads();
        u32x4 ctr[4];
        { const bf16_t* src = cprev + (size_t)(((b * 4 + h) * 2 + 0) * 32 + pc) * 16384 + (tid >> 2) * 128 + (tid & 3) * 32;
#pragma unroll
          for (int c8 = 0; c8 < 4; ++c8) ctr[c8] = *(const u32x4*)(src + c8 * 8); }
        u32x4 qraw[8], kraw[8], vraw[4];
        conv_load<true>(P, tokbase, l0, h * 128 + cc * 8, rg, qraw);
#pragma unroll
        for (int i = 0; i < 4; ++i) vraw[i] = __builtin_nontemporal_load((const u32x4*)(P + (tokbase + l0 + rg * 4 + i) * PN + 1024 + h * 128 + cc * 8));
        if (wid < 2) { float gt, am; gate_scan(gates + (tokbase + l0) * 16, h, wid, lane, sm + wid * 512, sm + wid * 512 + 128, sm + wid * 512 + 256, gt, am);
            if (lane == 0) sm[2176 + wid] = mprev[((b * 4 + h) * 2 + wid) * 32 + pc]; }
        { float x[4][8]; conv_compute(qraw, cw, h * 128 + cc * 8, 0.08838834764831845f, x);
#pragma unroll
          for (int i = 0; i < 4; ++i) { u32x4 w; w.x = pk2(x[i][0], x[i][1]); w.y = pk2(x[i][2], x[i][3]); w.z = pk2(x[i][4], x[i][5]); w.w = pk2(x[i][6], x[i][7]); *(LAS u32x4*)(QS + (rg * 4 + i) * TP + cc * 8) = w; } }
        conv_load<true>(P, tokbase, l0, 512 + h * 128 + cc * 8, rg, kraw);
        { float x[4][8]; conv_compute(kraw, cw, 512 + h * 128 + cc * 8, 1.f, x);
#pragma unroll
          for (int i = 0; i < 4; ++i) { u32x4 w; w.x = pk2(x[i][0], x[i][1]); w.y = pk2(x[i][2], x[i][3]); w.z = pk2(x[i][4], x[i][5]); w.w = pk2(x[i][6], x[i][7]); *(LAS u32x4*)(KS + (rg * 4 + i) * TP + cc * 8) = w; } }
        { float v[4][8];
#pragma unroll
          for (int i = 0; i < 4; ++i) unpack8(vraw[i], v[i]);
#pragma unroll
          for (int e = 0; e < 8; ++e) { u32x2 a; a.x = pk2(v[0][e], v[1][e]); a.y = pk2(v[2][e], v[3][e]); *(LAS u32x2*)(VT + (cc * 8 + e) * TP + rg * 4) = a; } }
        __syncthreads();
        f32x4 sacc[2][4]; zero_acc(sacc);
        mm128T(sacc, QS, KS, wr, wc, fr, fq);
        f32x4 hsum[2][4]; zero_acc(hsum);
#pragma unroll 1
        for (int d = 0; d < 2; ++d) {
            __syncthreads();
            const size_t sidx = (size_t)(((b * 4 + h) * 2 + d) * 32 + pc);
            { const int r = tid >> 2, q = tid & 3;
#pragma unroll
              for (int c8 = 0; c8 < 4; ++c8) *(LAS u32x4*)(CT + r * TP + q * 32 + c8 * 8) = ctr[c8];
              if (d == 0) { const bf16_t* src = cprev + (sidx + 32) * 16384 + r * 128 + q * 32;
#pragma unroll
                  for (int c8 = 0; c8 < 4; ++c8) ctr[c8] = *(const u32x4*)(src + c8 * 8); } }
            if (tid < 128) sm[1024 + tid] = nprev[sidx * 128 + tid];
            const float mp = sm[2176 + d];
            LAS float* av = sm + d * 512; LAS float* bv = av + 128; LAS float* cm = av + 256;
#pragma unroll
            for (int mt = 0; mt < 2; ++mt) { const int t = wr * 32 + mt * 16 + fr; const float Mt = fmaxf(mp, cm[t]); float rsum = 0.f;
#pragma unroll
                for (int nt = 0; nt < 4; ++nt) { const int s0 = wc * 64 + nt * 16 + fq * 4; float pv[4];
#pragma unroll
                    for (int jj = 0; jj < 4; ++jj) { const int s = s0 + jj; const bool ok = d ? (s >= t) : (s <= t);
                        const float wgt = ok ? __expf(av[s] - Mt) : 0.f; pv[jj] = sacc[mt][nt][jj] * wgt; rsum += pv[jj]; }
                    u32x2 o; o.x = pk2(pv[0], pv[1]); o.y = pk2(pv[2], pv[3]); *(LAS u32x2*)(KS + t * TP + s0) = o; }
                rsum = rows4_sum(rsum);
                if (fq == 0) sm[1152 + wc * 128 + t] = rsum; }
            __syncthreads();
            { const int t = tid & 127, part = tid >> 7; float s = 0.f;
#pragma unroll
              for (int q = 0; q < 4; ++q) { const u32x4 w = *(const LAS u32x4*)(QS + t * TP + part * 32 + q * 8); float x[8]; unpack8(w, x);
#pragma unroll
                  for (int e = 0; e < 8; ++e) s += x[e] * sm[1024 + part * 32 + q * 8 + e]; }
              sm[1408 + part * 128 + t] = s; }
            f32x4 a1[2][4], a2[2][4]; zero_acc(a1); zero_acc(a2);
            mm128T(a1, KS, VT, wr, wc, fr, fq);
            mm128T(a2, QS, CT, wr, wc, fr, fq);
            __syncthreads();
#pragma unroll
            for (int mt = 0; mt < 2; ++mt) { const int t = wr * 32 + mt * 16 + fr; const float Mt = fmaxf(mp, cm[t]);
                const float inter = __expf(mp - Mt);
                const float qn = (sm[1408 + t] + sm[1536 + t]) + (sm[1664 + t] + sm[1792 + t]);
                const float den = sm[1152 + t] + sm[1280 + t] + inter * qn;
                const float dn = fmaxf(fabsf(den), __expf(-(bv[t] + Mt)));
                const float inv = 1.f / dn;
#pragma unroll
                for (int nt = 0; nt < 4; ++nt) hsum[mt][nt] += (a1[mt][nt] + a2[mt][nt] * inter) * inv; }
        }
#pragma unroll
        for (int mt = 0; mt < 2; ++mt) { const int t = wr * 32 + mt * 16 + fr; float ss = 0.f;
#pragma unroll
            for (int nt = 0; nt < 4; ++nt) ss += (hsum[mt][nt][0] * hsum[mt][nt][0] + hsum[mt][nt][1] * hsum[mt][nt][1]) + (hsum[mt][nt][2] * hsum[mt][nt][2] + hsum[mt][nt][3] * hsum[mt][nt][3]);
            ss = rows4_sum(ss);
            if (fq == 0) sm[1920 + wc * 128 + t] = ss; }
        u32x2 oraw[2][4];
#pragma unroll
        for (int mt = 0; mt < 2; ++mt)
#pragma unroll
            for (int nt = 0; nt < 4; ++nt) oraw[mt][nt] = __builtin_nontemporal_load((const u32x2*)(P + (tokbase + l0 + wr * 32 + mt * 16 + fr) * PN + 1536 + h * 128 + wc * 64 + nt * 16 + fq * 4));
        __syncthreads();
#pragma unroll
        for (int mt = 0; mt < 2; ++mt) { const int t = wr * 32 + mt * 16 + fr; const float rs = 1.f / sqrtf((sm[1920 + t] + sm[2048 + t]) * (1.f / 128.f) + EPS);
            const size_t row = tokbase + l0 + t;
#pragma unroll
            for (int nt = 0; nt < 4; ++nt) { const int e = wc * 64 + nt * 16 + fq * 4;
                const f32x4 g4 = *(const f32x4*)(hg + h * 128 + e);
                const u32x2 ow = oraw[mt][nt];
                const float o0 = bflo(ow.x), o1 = bfhi(ow.x), o2 = bflo(ow.y), o3 = bfhi(ow.y);
                const float y0 = hsum[mt][nt][0] * rs * g4.x * __builtin_amdgcn_rcpf(1.f + __expf(-o0));
                const float y1 = hsum[mt][nt][1] * rs * g4.y * __builtin_amdgcn_rcpf(1.f + __expf(-o1));
                const float y2 = hsum[mt][nt][2] * rs * g4.z * __builtin_amdgcn_rcpf(1.f + __expf(-o2));
                const float y3 = hsum[mt][nt][3] * rs * g4.w * __builtin_amdgcn_rcpf(1.f + __expf(-o3));
                u32x2 o; o.x = pk2(y0, y1); o.y = pk2(y2, y3);
                *(u32x2*)(hab + row * DM + h * 128 + e) = o; } }
    }
}

namespace att {
constexpr int KVBLK = 64, QBLK = 32, NW = 8;
constexpr float SCALE = 0.10206207261596575f;
constexpr float THR = 8.f;
constexpr int SHM_V = KVBLK * 128 * 2, SHM_K = KVBLK * 128 * 2;
#define KSWZ(row, colB) ((row) * 256 + ((colB) ^ (((row) & 7) << 4)))
#define SBAR() __builtin_amdgcn_sched_barrier(0)
__device__ __forceinline__ int crow(int r, int hi) { return (r & 3) + 8 * (r >> 2) + 4 * hi; }
__device__ __forceinline__ void partialSM(f32x16& p0, f32x16& p1, float& m_reg, float& mn, float& alpha) {
    constexpr float Cc = SCALE * 1.4426950408889634f;
    float pmax = p0[0];
#pragma unroll
    for (int r = 1; r < 16; ++r) pmax = fmaxf(pmax, p0[r]);
#pragma unroll
    for (int r = 0; r < 16; ++r) pmax = fmaxf(pmax, p1[r]);
    { auto rr = __builtin_amdgcn_permlane32_swap(__float_as_uint(pmax), __float_as_uint(pmax), false, false);
      pmax = fmaxf(__uint_as_float(rr[0]), __uint_as_float(rr[1])); }
    if (__builtin_expect(__all(pmax - m_reg <= THR / SCALE), 1)) { mn = m_reg; alpha = 1.f; }
    else { mn = fmaxf(m_reg, pmax); alpha = __builtin_amdgcn_exp2f((m_reg - mn) * Cc); m_reg = mn; }
    const float mnC = -mn * Cc;
    { typedef float f32x2 __attribute__((ext_vector_type(2))); const f32x2 c2 = {Cc, Cc}, m2 = {mnC, mnC};
#pragma unroll
      for (int r = 0; r < 16; r += 2) { f32x2 t = {p0[r], p0[r + 1]}; t = __builtin_elementwise_fma(t, c2, m2); p0[r] = t.x; p0[r + 1] = t.y; }
#pragma unroll
      for (int r = 0; r < 16; r += 2) { f32x2 t = {p1[r], p1[r + 1]}; t = __builtin_elementwise_fma(t, c2, m2); p1[r] = t.x; p1[r + 1] = t.y; } }
#pragma unroll
    for (int r = 0; r < 16; ++r) p0[r] = __builtin_amdgcn_exp2f(p0[r]);
}
__device__ __forceinline__ void finishSM(f32x16& p0, f32x16& p1, float alpha, float& l_reg, bf16x8& pa0, bf16x8& pa1, bf16x8& pa2, bf16x8& pa3) {
#pragma unroll
    for (int r = 0; r < 16; ++r) p1[r] = __builtin_amdgcn_exp2f(p1[r]);
    float ps;
    { typedef float f32x2 __attribute__((ext_vector_type(2))); f32x2 s0 = {p0[0], p0[1]}, s1 = {p1[0], p1[1]};
#pragma unroll
      for (int r = 2; r < 16; r += 2) { s0 += (f32x2){p0[r], p0[r + 1]}; s1 += (f32x2){p1[r], p1[r + 1]}; }
      s0 += s1; ps = s0.x + s0.y; }
    { auto rr = __builtin_amdgcn_permlane32_swap(__float_as_uint(ps), __float_as_uint(ps), false, false);
      ps = __uint_as_float(rr[0]) + __uint_as_float(rr[1]); }
    l_reg = l_reg * alpha + ps;
#define PK4(P, BASE, OUT) do { unsigned a0 = cvtpk(P[BASE + 0], P[BASE + 1]), a1 = cvtpk(P[BASE + 2], P[BASE + 3]);   \
    unsigned b0 = cvtpk(P[BASE + 4], P[BASE + 5]), b1 = cvtpk(P[BASE + 6], P[BASE + 7]);                              \
    auto r0 = __builtin_amdgcn_permlane32_swap(a0, b0, false, false); auto r1 = __builtin_amdgcn_permlane32_swap(a1, b1, false, false); \
    u32x4 w = {r0[0], r1[0], r0[1], r1[1]}; OUT = *reinterpret_cast<bf16x8*>(&w); } while (0)
    PK4(p0, 0, pa0); PK4(p0, 8, pa1); PK4(p1, 0, pa2); PK4(p1, 8, pa3);
#undef PK4
}
__device__ __forceinline__ void qkt(f32x16& p0, f32x16& p1, const char* Ks, const bf16x8* qr, int r32, int hi) {
    p0 = f32x16{}; p1 = f32x16{};
#pragma unroll
    for (int d0 = 0; d0 < 6; ++d0) { const int cb = (d0 * 16 + hi * 8) * 2;
        bf16x8 b0 = *reinterpret_cast<const bf16x8*>(Ks + KSWZ(r32, cb));
        bf16x8 b1 = *reinterpret_cast<const bf16x8*>(Ks + KSWZ(32 + r32, cb));
        p0 = __builtin_amdgcn_mfma_f32_32x32x16_bf16(b0, qr[d0], p0, 0, 0, 0);
        p1 = __builtin_amdgcn_mfma_f32_32x32x16_bf16(b1, qr[d0], p1, 0, 0, 0); }
}
__device__ __forceinline__ int v_st(int k, int c) { const int kk = (k & ~0xC) | ((k & 4) << 1) | ((k & 8) >> 1); return ((kk >> 3) * 4 + (c >> 5)) * 512 + ((kk & 7) * 32 + (c & 31)) * 2; }
__device__ __forceinline__ int v_rd_base(int lane) { return ((lane & 3) << 3) | (((lane >> 2) & 3) << 6) | (((lane >> 4) & 1) << 5) | (((lane >> 5) & 1) << 8); }
constexpr int v_rd_off(int d0, int ks, int half) { return d0 * 512 + ks * 4096 + half * 2048; }
template <int OFF> __device__ __forceinline__ s16x4 tr_read(int vb) {
    s16x4 r; asm volatile("ds_read_b64_tr_b16 %0, %1 offset:%2" : "=&v"(r) : "v"(vb), "i"(OFF) : "memory"); return r;
}
template <int D0> __device__ __forceinline__ void pv_one(f32x16& od, int vb, bf16x8 pa0, bf16x8 pa1, bf16x8 pa2, bf16x8 pa3) {
    const s16x4 l0 = tr_read<v_rd_off(D0, 0, 0)>(vb), h0 = tr_read<v_rd_off(D0, 0, 1)>(vb), l1 = tr_read<v_rd_off(D0, 1, 0)>(vb), h1 = tr_read<v_rd_off(D0, 1, 1)>(vb);
    const s16x4 l2 = tr_read<v_rd_off(D0, 2, 0)>(vb), h2 = tr_read<v_rd_off(D0, 2, 1)>(vb), l3 = tr_read<v_rd_off(D0, 3, 0)>(vb), h3 = tr_read<v_rd_off(D0, 3, 1)>(vb);
    asm volatile("s_waitcnt lgkmcnt(0)" ::: "memory"); SBAR();
#define PK(L, H) (bf16x8){L[0], L[1], L[2], L[3], H[0], H[1], H[2], H[3]}
    od = __builtin_amdgcn_mfma_f32_32x32x16_bf16(pa0, PK(l0, h0), od, 0, 0, 0);
    od = __builtin_amdgcn_mfma_f32_32x32x16_bf16(pa1, PK(l1, h1), od, 0, 0, 0);
    od = __builtin_amdgcn_mfma_f32_32x32x16_bf16(pa2, PK(l2, h2), od, 0, 0, 0);
    od = __builtin_amdgcn_mfma_f32_32x32x16_bf16(pa3, PK(l3, h3), od, 0, 0, 0);
#undef PK
}
__device__ __forceinline__ void pv_d0(f32x16* o, int vb, bf16x8 pa0, bf16x8 pa1, bf16x8 pa2, bf16x8 pa3) {
    pv_one<0>(o[0], vb, pa0, pa1, pa2, pa3); pv_one<1>(o[1], vb, pa0, pa1, pa2, pa3);
}
__device__ __forceinline__ void attn_body(const bf16_t* __restrict__ Qb, const bf16_t* __restrict__ KVh, const bf16_t* __restrict__ KR, const float* __restrict__ ropeq,
                                          bf16_t* __restrict__ Ob, int seq, char* lds, const int tid) {
    const int wid = tid >> 6, lane = tid & 63, r32 = lane & 31, hi = lane >> 5;
    char* V_lds = lds; char* K_lds = lds + 3 * SHM_V;
    float* wsm = (float*)(lds + 3 * SHM_V + 3 * SHM_K) + wid * 64; float* li_l = wsm; float* al_l = wsm + 32;
    float m_reg = -1e30f, l_reg = 0; f32x16 o[2] = {}; bf16x8 qr[6];
    { const bf16_t* Qw = Qb + (size_t)(wid * QBLK + r32) * NQ + hi * 8;
#pragma unroll
      for (int d0 = 0; d0 < 4; ++d0) qr[d0] = *reinterpret_cast<const bf16x8*>(Qw + d0 * 16);
      const u32x4 w1 = *reinterpret_cast<const u32x4*>(Qw + 64), w2 = *reinterpret_cast<const u32x4*>(Qw + 80);
      float x1[8], x2[8]; unpack8(w1, x1); unpack8(w2, x2);
      const float* rp = ropeq + (size_t)(wid * QBLK + r32) * 32 + hi * 8;
      float y1[8], y2[8];
#pragma unroll
      for (int e = 0; e < 8; ++e) { const float c = rp[e], s = rp[16 + e]; y1[e] = x1[e] * c - x2[e] * s; y2[e] = x1[e] * s + x2[e] * c; }
      u32x4 o1 = {pk2(y1[0], y1[1]), pk2(y1[2], y1[3]), pk2(y1[4], y1[5]), pk2(y1[6], y1[7])};
      u32x4 o2 = {pk2(y2[0], y2[1]), pk2(y2[2], y2[3]), pk2(y2[4], y2[5]), pk2(y2[6], y2[7])};
      qr[4] = *reinterpret_cast<bf16x8*>(&o1); qr[5] = *reinterpret_cast<bf16x8*>(&o2); }
    const int sr = tid >> 4, c16 = tid & 15;
    const bool isK = c16 < 8;
    const int kst0 = KSWZ(sr, c16 * 16), kst1 = KSWZ(32 + sr, c16 * 16), vst0 = v_st(sr, (c16 & 7) * 8), vst1 = v_st(32 + sr, (c16 & 7) * 8);
    const int rkey = (tid & 255) >> 2, rch = tid & 3; const int rst = KSWZ(rkey, 128 + rch * 16); const bool rwr = tid < 256;
    const int vb0 = (int)(uintptr_t)V_lds + v_rd_base(lane);
    struct { bf16x8 a0, a1, rr; } sr_[2];
#define SLOAD(i, k0) do { sr_[i].a0 = *reinterpret_cast<const bf16x8*>(&KVh[(size_t)((k0) + sr) * NKV + c16 * 8]); sr_[i].a1 = *reinterpret_cast<const bf16x8*>(&KVh[(size_t)((k0) + 32 + sr) * NKV + c16 * 8]); \
    sr_[i].rr = *reinterpret_cast<const bf16x8*>(&KR[(size_t)((k0) + rkey) * 32 + rch * 8]); } while (0)
#define SWRITE(b, i) do { if (isK) { *(bf16x8*)(K_lds + (b) * SHM_K + kst0) = sr_[i].a0; *(bf16x8*)(K_lds + (b) * SHM_K + kst1) = sr_[i].a1; } \
    else { *(bf16x8*)(V_lds + (b) * SHM_V + vst0) = sr_[i].a0; *(bf16x8*)(V_lds + (b) * SHM_V + vst1) = sr_[i].a1; } \
    if (rwr) *(bf16x8*)(K_lds + (b) * SHM_K + rst) = sr_[i].rr; } while (0)
#define SWAIT() asm volatile("s_waitcnt vmcnt(3)" ::: "memory")
#define RESC(a) do { if (__any((a) < 1.f)) { if (hi == 0) al_l[r32] = (a); asm volatile("s_waitcnt lgkmcnt(0)" ::: "memory"); \
    _Pragma("unroll") for (int d = 0; d < 2; ++d) _Pragma("unroll") for (int r = 0; r < 16; ++r) o[d][r] *= al_l[crow(r, hi)]; } } while (0)
    f32x16 pA0, pA1, pB0, pB1; float mnA, mnB, alA, alB; bf16x8 pa0, pa1, pa2, pa3; const int NT = seq / KVBLK;
    constexpr int SE = 0, SO = 1;
    SLOAD(SE, 0); asm volatile("s_waitcnt vmcnt(0)" ::: "memory"); SWRITE(0, SE); __syncthreads();
    qkt(pA0, pA1, K_lds, qr, r32, hi); partialSM(pA0, pA1, m_reg, mnA, alA);
    SLOAD(SO, KVBLK); if (2 < NT) SLOAD(SE, 2 * KVBLK);
    SWAIT(); SWRITE(1, SO); __syncthreads();
    int bp = 0, bc = 1, bn = 2;
    for (int j = 1; j + 1 < NT; j += 2) {
        SBAR(); qkt(pB0, pB1, K_lds + bc * SHM_K, qr, r32, hi);
        finishSM(pA0, pA1, alA, l_reg, pa0, pa1, pa2, pa3); SBAR();
        SLOAD(SO, (j + 2) * KVBLK); SBAR();
        pv_d0(o, vb0 + bp * (int)SHM_V, pa0, pa1, pa2, pa3); partialSM(pB0, pB1, m_reg, mnB, alB);
        SWAIT(); SWRITE(bn, SE);
        RESC(alB); __syncthreads();
        { const int t = bp; bp = bc; bc = bn; bn = t; }
        SBAR(); qkt(pA0, pA1, K_lds + bc * SHM_K, qr, r32, hi);
        finishSM(pB0, pB1, alB, l_reg, pa0, pa1, pa2, pa3); SBAR();
        if (j + 3 < NT) SLOAD(SE, (j + 3) * KVBLK); SBAR();
        pv_d0(o, vb0 + bp * (int)SHM_V, pa0, pa1, pa2, pa3); partialSM(pA0, pA1, m_reg, mnA, alA);
        SWAIT(); SWRITE(bn, SO);
        RESC(alA); __syncthreads();
        { const int t = bp; bp = bc; bc = bn; bn = t; }
    }
    SBAR(); qkt(pB0, pB1, K_lds + bc * SHM_K, qr, r32, hi);
    finishSM(pA0, pA1, alA, l_reg, pa0, pa1, pa2, pa3); SBAR();
    pv_d0(o, vb0 + bp * (int)SHM_V, pa0, pa1, pa2, pa3); partialSM(pB0, pB1, m_reg, mnB, alB);
    RESC(alB);
    finishSM(pB0, pB1, alB, l_reg, pa0, pa1, pa2, pa3); SBAR();
    pv_d0(o, vb0 + bc * (int)SHM_V, pa0, pa1, pa2, pa3);
    if (hi == 0) li_l[r32] = l_reg; asm volatile("s_waitcnt lgkmcnt(0)" ::: "memory");
    float rli[16];
#pragma unroll
    for (int r = 0; r < 16; ++r) rli[r] = __builtin_amdgcn_rcpf(li_l[crow(r, hi)]);
    bf16_t* Ow = Ob + (size_t)(wid * QBLK) * DM;
#pragma unroll
    for (int r = 0; r < 16; ++r) { const int orow = crow(r, hi);
#pragma unroll
        for (int d0 = 0; d0 < 2; ++d0) Ow[(size_t)orow * DM + d0 * 32 + r32] = (bf16_t)f2bf(o[d0][r] * rli[r]); }
#undef SLOAD
#undef SWRITE
#undef SWAIT
#undef RESC
}
}

__device__ __forceinline__ void phase_attn(const Ctx& C, PP p, char* lds_generic) {
    unsigned char* ws = p->ws;
    const bf16_t* Q = (const bf16_t*)(ws + WS_BIG); const bf16_t* KV = (const bf16_t*)(ws + WS_KV); const bf16_t* KR = (const bf16_t*)(ws + WS_KR);
    const float* rope = (const float*)(ws + WS_ROPE); bf16_t* O = (bf16_t*)(ws + WS_HAB);
    for (int it = C.vcu; it < 2048; it += C.G) {
        const int qb = it & 15, h = (it >> 4) & 15, b = it >> 8; const size_t t0 = (size_t)b * SEQ, q0 = t0 + qb * 256;
        __syncthreads();
        att::attn_body(Q + q0 * NQ + h * 96, KV + t0 * NKV + h * 128, KR + t0 * 32, rope + q0 * 32, O + q0 * DM + h * 64, SEQ, lds_generic, C.tid);
    }
}


#define XB_TMO      128
#define XB_XCNT(j)  (256  + 64 * (j))
#define XB_XSUB(j)  (1280 + 64 * (j))
#define XB_XGEN(j)  (2304 + 64 * (j))
#define XB_TOP      3328
#define XB_TOPGEN   3392
#define XCD_BAR_WORDS 3456
#define XB_SPIN_CAP (1u << 22)
__device__ __forceinline__ unsigned xb_ld(unsigned* p)              { return __hip_atomic_load(p, __ATOMIC_RELAXED, __HIP_MEMORY_SCOPE_AGENT); }
__device__ __forceinline__ unsigned xb_add(unsigned* p, unsigned v) { return __hip_atomic_fetch_add(p, v, __ATOMIC_RELAXED, __HIP_MEMORY_SCOPE_AGENT); }
__device__ __forceinline__ unsigned xb_xcc_id() { return (unsigned)__builtin_amdgcn_s_getreg((3 << 11) | 20) & 0xFu; }
#define XB_SPIN(cond, bar) do { unsigned _sp = 0; while (cond) { __builtin_amdgcn_s_sleep(1); \
    if ((++_sp & 255u) == 0u) { if (xb_ld(&(bar)[XB_TMO])) break; if (_sp > XB_SPIN_CAP) { atomicAdd(&(bar)[XB_TMO], 1u); break; } } } } while (0)
__device__ __forceinline__ void xcd_barrier_complete(unsigned* bar, unsigned x, unsigned& nloc, unsigned& nx) {
    const unsigned G = gridDim.x * gridDim.y * gridDim.z;
    unsigned sum, cnt, mine, sp = 0u;
    for (;;) {
        sum = 0u; cnt = 0u; mine = 0u;
#pragma unroll
        for (unsigned j = 0; j < 16; ++j) { const unsigned c = xb_ld(&bar[XB_XCNT(j)]); sum += c; cnt += (c > 0u) ? 1u : 0u; mine = (j == x) ? c : mine; }
        if (sum == G) break;
        __builtin_amdgcn_s_sleep(1);
        if ((++sp & 255u) == 0u) { if (xb_ld(&bar[XB_TMO])) break; if (sp > XB_SPIN_CAP) { atomicAdd(&bar[XB_TMO], 1u); break; } }
    }
    nloc = mine > 0u ? mine : 1u; nx = cnt > 0u ? cnt : 1u;
}
__device__ __forceinline__ void xcd_barrier(unsigned* bar, volatile LAS unsigned* st) {
    asm volatile("s_waitcnt vmcnt(0)" ::: "memory");
    __syncthreads();
    if (threadIdx.x == 0) {
        const unsigned x = xb_xcc_id();
        __builtin_amdgcn_s_waitcnt(0);
        unsigned nloc = st[0], nx = st[1];
        if (nloc == 0u) { xcd_barrier_complete(bar, x, nloc, nx); st[0] = nloc; st[1] = nx; }
        const unsigned old = xb_add(&bar[XB_XSUB(x)], 1u);
        const unsigned gen = old / nloc;
        if (old + 1u == (gen + 1u) * nloc) {
            __builtin_amdgcn_fence(__ATOMIC_RELEASE, "agent");
            asm volatile("s_waitcnt vmcnt(0)" ::: "memory");
            const unsigned og = xb_add(&bar[XB_TOP], 1u);
            const unsigned tg = og / nx;
            if (og + 1u == (tg + 1u) * nx) xb_add(&bar[XB_TOPGEN], 1u);
            else XB_SPIN(xb_ld(&bar[XB_TOPGEN]) == tg, bar);
            __builtin_amdgcn_fence(__ATOMIC_ACQUIRE, "agent");
            xb_add(&bar[XB_XGEN(x)], 1u);
            asm volatile("s_waitcnt vmcnt(0)" ::: "memory");
        } else {
            XB_SPIN(xb_ld(&bar[XB_XGEN(x)]) == gen, bar);
            __builtin_amdgcn_fence(__ATOMIC_ACQUIRE, "agent");
            asm volatile("s_waitcnt vmcnt(0)" ::: "memory");
        }
    }
    __syncthreads();
}

constexpr int NPHASE = 42;
enum Kind { K_NOP = 0, K_PREP, K_NORM, K_GEMM_BF, K_GEMM_RES, K_M1, K_M2, K_M3, K_C2B, K_ATTN, K_FINAL };
__host__ __device__ inline int phase_kind(int ph) {
    if (ph == 0) return K_PREP; if (ph == NPHASE - 1) return K_FINAL;
    const int L = (ph - 1) / 10, s = (ph - 1) % 10;
    if ((L & 1) == 0) { const int k[10] = {K_NOP, K_GEMM_BF, K_M1, K_M2, K_M3, K_GEMM_RES, K_NOP, K_NOP, K_GEMM_BF, K_GEMM_RES}; return k[s]; }
    const int k[10] = {K_NOP, K_GEMM_BF, K_C2B, K_GEMM_BF, K_GEMM_BF, K_ATTN, K_GEMM_RES, K_NOP, K_GEMM_BF, K_GEMM_RES}; return k[s];
}
__host__ __device__ inline bool phase_sync_after(int ph) {
    if (ph == NPHASE - 1) return false;
    if (phase_kind(ph) == K_NOP) return false;
    const int L = (ph - 1) / 10, s = (ph - 1) % 10;
    if (ph > 0 && (L & 1) == 1 && s == 3) return false;
    return true;
}

__global__ void __launch_bounds__(NTHR, 2) mega(Params p_) {
    extern __shared__ __attribute__((aligned(16))) unsigned char lds_raw[];
    const int ph_hi = p_.ph_hi;
    volatile LAS unsigned* bst = (volatile LAS unsigned*)((LAS unsigned char*)lds_raw + LDS_BYTES - 16);
    if (threadIdx.x == 0) { bst[0] = 0u; bst[1] = 0u; if (ph_hi - p_.ph_lo > 1) (void)xb_add(&((unsigned*)p_.ws)[XB_XCNT(xb_xcc_id())], 1u); }
    __syncthreads();
    if (ph_hi > 100000) cg::this_grid().sync();
#define GRID_BAR() xcd_barrier((unsigned*)p->ws, bst)
#pragma unroll 1
    for (int ph = p_.ph_lo; ph < ph_hi; ++ph) {
        PP p = (PP)__builtin_amdgcn_kernarg_segment_ptr(); asm volatile("" : "+s"(p));
        unsigned char* ws = p->ws;
        float* xres = p->out;
        bf16_t* XN = (bf16_t*)(ws + WS_XN); bf16_t* HAB = (bf16_t*)(ws + WS_HAB); bf16_t* BIG = (bf16_t*)(ws + WS_BIG);
        const int kind = phase_kind(ph);
#pragma unroll 1
        for (int rep = 0; rep < (((DUP_MASK >> kind) & 1) ? 2 : 1); ++rep) {
        if (rep) GRID_BAR();
        int tid_ = threadIdx.x; asm volatile("" : "+v"(tid_));
        Ctx C; C.lds = (LAS unsigned char*)lds_raw; C.tid = tid_; C.lane = C.tid & 63; C.wave = __builtin_amdgcn_readfirstlane(C.tid >> 6);
        C.G = gridDim.x; { const int bx = blockIdx.x; C.vcu = (C.G % 8 == 0) ? (bx % 8) * (C.G / 8) + bx / 8 : bx; }
        const int L = (ph - 1) / 10, s = (ph - 1) % 10, j = L >> 1; const bool odd = (L & 1) != 0;
        switch (kind) {
        case K_PREP: phase_prep(C, p); break;
        case K_GEMM_BF: {
            pg8::Gemm g; pg8::EpiBf E;
            const float* SS = (const float*)(ws + WS_SS); const LAS float* RST = (const LAS float*)(C.lds + 131072);
            const bf16_t* XR = (const bf16_t*)xres;
            if (s == 8) { g = pg8::Gemm{XR, (const bf16_t*)(ws + W_F1) + (size_t)L * DFF * DM, TOK, DFF, DM}; E = pg8::EpiBf{BIG, DFF, 1, RST, nullptr, nullptr}; }
            else if (!odd) { g = pg8::Gemm{XR, (const bf16_t*)(ws + W_ABIN) + (size_t)j * PNG * DM, TOK, PN, DM}; E = pg8::EpiBf{BIG, PN, 2, RST, (float*)(ws + WS_GATES), p->in[I_ABGB] + (size_t)j * 16}; }
            else if (s == 1) { g = pg8::Gemm{XR, (const bf16_t*)(ws + W_CIN) + (size_t)j * CINP * DM, TOK, CINP, DM}; E = pg8::EpiBf{HAB, CINP, 0, RST, nullptr, nullptr}; }
            else if (s == 3) { g = pg8::Gemm{(const bf16_t*)(ws + WS_CQN), (const bf16_t*)(ws + W_CUQ) + (size_t)j * NQ * QL, TOK, NQ, QL}; E = pg8::EpiBf{BIG, NQ, 0, nullptr, nullptr, nullptr}; }
            else { g = pg8::Gemm{(const bf16_t*)(ws + WS_CKVN), (const bf16_t*)(ws + W_CUKV) + (size_t)j * NKV * KVL, TOK, NKV, KVL}; E = pg8::EpiBf{(bf16_t*)(ws + WS_KV), NKV, 0, nullptr, nullptr, nullptr}; }
            pg8::StaticOrder S; S.init(g.M, g.N, C.G, (int)blockIdx.x);
            if (E.rst) {
                LAS float* rw = (LAS float*)(C.lds + 131072); LAS int* upm = (LAS int*)(C.lds + 131072 + 8192);
                if (C.tid < 8) { pg8::Unit uu; upm[C.tid] = S.next(C.tid, uu) ? uu.pm : -1; }
                __syncthreads();
                const int par = C.wave >> 2, rrow = C.tid & 255;
                const int pm0 = upm[par], pm1 = upm[par + 2], pm2 = upm[par + 4], pm3 = upm[par + 6];
                f32x4 t0 = (f32x4){0.f, 0.f, 0.f, 0.f}, t1 = t0, t2 = t0, t3 = t0;
                if (pm0 >= 0) { const float* sp = SS + (size_t)(pm0 * 256 + rrow) * 16; t0 = (*(const f32x4*)(sp) + *(const f32x4*)(sp + 4)) + (*(const f32x4*)(sp + 8) + *(const f32x4*)(sp + 12)); }
                if (pm1 >= 0) { const float* sp = SS + (size_t)(pm1 * 256 + rrow) * 16; t1 = (*(const f32x4*)(sp) + *(const f32x4*)(sp + 4)) + (*(const f32x4*)(sp + 8) + *(const f32x4*)(sp + 12)); }
                if (pm2 >= 0) { const float* sp = SS + (size_t)(pm2 * 256 + rrow) * 16; t2 = (*(const f32x4*)(sp) + *(const f32x4*)(sp + 4)) + (*(const f32x4*)(sp + 8) + *(const f32x4*)(sp + 12)); }
                if (pm3 >= 0) { const float* sp = SS + (size_t)(pm3 * 256 + rrow) * 16; t3 = (*(const f32x4*)(sp) + *(const f32x4*)(sp + 4)) + (*(const f32x4*)(sp + 8) + *(const f32x4*)(sp + 12)); }
                if (pm0 >= 0) rw[(par + 0) * 256 + rrow] = 1.f / sqrtf(((t0.x + t0.y) + (t0.z + t0.w)) * (1.f / DM) + EPS);
                if (pm1 >= 0) rw[(par + 2) * 256 + rrow] = 1.f / sqrtf(((t1.x + t1.y) + (t1.z + t1.w)) * (1.f / DM) + EPS);
                if (pm2 >= 0) rw[(par + 4) * 256 + rrow] = 1.f / sqrtf(((t2.x + t2.y) + (t2.z + t2.w)) * (1.f / DM) + EPS);
                if (pm3 >= 0) rw[(par + 6) * 256 + rrow] = 1.f / sqrtf(((t3.x + t3.y) + (t3.z + t3.w)) * (1.f / DM) + EPS);
                __syncthreads(); }
            if (!odd && s == 1) {
                const bf16_t* WGt = (const bf16_t*)(ws + W_ABIN) + (size_t)j * PNG * DM + (size_t)PN * DM; const float* gb = p->in[I_ABGB] + (size_t)j * 16; float* gates = (float*)(ws + WS_GATES);
                const int fr = C.lane & 15, fq = C.lane >> 4;
                for (int rg = C.vcu * 8 + C.wave; rg < TOK / 16; rg += C.G * 8) { const int r0 = rg * 16;
                    f32x4 ga = (f32x4){0.f, 0.f, 0.f, 0.f};
                    const bf16_t* ap = XR + (size_t)(r0 + fr) * DM + fq * 8; const bf16_t* bp = WGt + (size_t)fr * DM + fq * 8;
#pragma unroll 16
                    for (int kk = 0; kk < 32; ++kk) { const bf16x8 av = *(const bf16x8*)(ap + kk * 32), bv = *(const bf16x8*)(bp + kk * 32); ga = __builtin_amdgcn_mfma_f32_16x16x32_bf16(av, bv, ga, 0, 0, 0); }
                    const float* sp = SS + (size_t)(r0 + fr) * 16;
                    const f32x4 t = (*(const f32x4*)(sp) + *(const f32x4*)(sp + 4)) + (*(const f32x4*)(sp + 8) + *(const f32x4*)(sp + 12));
                    const float rsl = 1.f / sqrtf(((t.x + t.y) + (t.z + t.w)) * (1.f / DM) + EPS);
                    const float bq = gb[fr];
#pragma unroll
                    for (int jj = 0; jj < 4; ++jj) { const int mrow = fq * 4 + jj; float x = ga[jj] * __shfl(rsl, mrow) + bq;
                        if ((fr >> 2) & 1) x = fminf(x, 0.f) - log1pf(__expf(-fabsf(x)));
                        gates[(size_t)(r0 + mrow) * 16 + fr] = x; } } }
            pg8::gemm_phase<pg8::EpiBf>(C.lds, g, S, E, C.tid);
        } break;
        case K_GEMM_RES: {
            pg8::Gemm g; pg8::EpiRes E;
            float* SS = (float*)(ws + WS_SS);
            bf16_t* XR = (bf16_t*)xres;
            if (s == 9) { g = pg8::Gemm{BIG, (const bf16_t*)(ws + W_F2) + (size_t)L * DM * DFF, TOK, DM, DFF}; E = pg8::EpiRes{XR, (L == 3) ? XN : XR, SS}; }
            else if (!odd) { g = pg8::Gemm{HAB, (const bf16_t*)(ws + W_ABOUT) + (size_t)j * DM * DM, TOK, DM, DM}; E = pg8::EpiRes{XR, XR, SS}; }
            else { g = pg8::Gemm{HAB, (const bf16_t*)(ws + W_COUT) + (size_t)j * DM * DM, TOK, DM, DM}; E = pg8::EpiRes{XR, XR, SS}; }
            pg8::StaticOrder S; S.init(g.M, g.N, C.G, (int)blockIdx.x);
            pg8::gemm_phase<pg8::EpiRes>(C.lds, g, S, E, C.tid);
        } break;
        case K_M1: phase_m1_sgu(C, p, j); break;
        case K_M2: phase_m2(C, p); break;
        case K_M3: phase_m3(C, p, j); break;
        case K_C2B: phase_c2b(C, HAB, p->in[I_CQG] + (size_t)j * QL, p->in[I_CKVG] + (size_t)j * KVL, (const float*)(ws + WS_ROPE), (bf16_t*)(ws + WS_CQN), (bf16_t*)(ws + WS_CKVN), (bf16_t*)(ws + WS_KR)); break;
        case K_ATTN: phase_attn(C, p, (char*)lds_raw); __syncthreads(); break;
        case K_FINAL: phase_final_norm(C, XN, xres, p->in[I_FINAL]); break;
        default: break;
        }
        }
        if (ph + 1 < ph_hi && phase_sync_after(ph)) { GRID_BAR(); }
        else __syncthreads();
    }
}

extern "C" void kernel_launch(void* const* d_in, const int* in_sizes, int n_in, void* d_out, int out_size, void* d_ws, size_t ws_size, hipStream_t stream) {
    static int grid = 0;
    if (grid == 0) {
        if (n_in != 22 || out_size != TOK * DM || ws_size < WS_END) { fprintf(stderr, "kernel_launch: unexpected shapes n_in %d out %d ws %zu (need %zu)\n", n_in, out_size, ws_size, (size_t)WS_END); grid = -1; return; }
        int dev = 0, cus = 0, per_cu = 0;
        hipGetDevice(&dev); hipDeviceGetAttribute(&cus, hipDeviceAttributeMultiprocessorCount, dev);
        if (hipFuncSetAttribute((const void*)mega, hipFuncAttributeMaxDynamicSharedMemorySize, LDS_BYTES) != hipSuccess) { fprintf(stderr, "kernel_launch: hipFuncSetAttribute failed\n"); grid = -1; return; }
        if (hipOccupancyMaxActiveBlocksPerMultiprocessor(&per_cu, (const void*)mega, NTHR, LDS_BYTES) != hipSuccess || per_cu < 1) { fprintf(stderr, "kernel_launch: occupancy query says %d\n", per_cu); per_cu = 1; }
        (void)hipGetLastError();
        grid = cus * 1;
        if (grid <= 0) grid = 256;
    }
    if (grid < 0) return;
    if (hipMemsetAsync(d_ws, 0, 16384, stream) != hipSuccess) { fprintf(stderr, "kernel_launch: memset failed\n"); return; }
    Params hp{};
    for (int i = 0; i < 22; ++i) hp.in[i] = (const float*)d_in[i];
    hp.out = (float*)d_out; hp.ws = (unsigned char*)d_ws;
#if MK_MULTI
    for (int ph = 0; ph < NPHASE; ++ph) {
        if (phase_kind(ph) == K_NOP) continue;
        hp.ph_lo = ph; hp.ph_hi = ph + 1;
        hipLaunchKernelGGL(mega, dim3(grid), dim3(NTHR), LDS_BYTES, stream, hp);
    }
#else
    hp.ph_lo = 0; hp.ph_hi = NPHASE;
    void* args[] = {&hp};
    hipError_t e = hipLaunchCooperativeKernel((const void*)mega, dim3(grid), dim3(NTHR), args, LDS_BYTES, stream);
    if (e != hipSuccess) fprintf(stderr, "cooperative launch failed: %s (grid %d)\n", hipGetErrorString(e), grid);
#endif
}
```
